# Optimizing an MI355X kernel written in HIP

```python
import jax, jax.numpy as jnp
from jax import lax
import numpy as np

D_MODEL = 2048
BATCH = 2
SEQ = 16384
DEPTH = 4

N_MIXERS = 2
HEAD_DIM = 128
ATTN_SLOTS = 16
ATTN_WIDTH = ATTN_SLOTS * HEAD_DIM
DILATION_GROUPS = ((128, 1), (512, 4), (2048, 16))
N_GROUPS = len(DILATION_GROUPS)
QKV_WIDTH = 3 * N_GROUPS * ATTN_WIDTH
ATTN_IN_WIDTH = QKV_WIDTH + ATTN_WIDTH
BLOCK_Q = 128
CONV_WIDTH = D_MODEL
CONV_K = 3
CONV_IN_WIDTH = 4 * CONV_WIDTH
NORM_EPS = 1e-6

kernel_name = "hybrid_dilated_swa_shortconv"


def alibi_slopes():
    n = N_GROUPS * ATTN_SLOTS
    s = 2.0 ** (-8.0 * np.arange(1, n + 1) / n)
    return s.reshape(N_GROUPS, ATTN_SLOTS).astype(np.float32)


def rmsnorm(x, g):
    xf = x.astype(jnp.float32)
    y = xf * lax.rsqrt(jnp.mean(xf * xf, axis=-1, keepdims=True) + NORM_EPS) * g.astype(jnp.float32)
    return y.astype(x.dtype)


def to_residues(t, d):
    b, s = t.shape[:2]
    rest = t.shape[2:]
    t = t.reshape((b, s // d, d) + rest)
    t = jnp.moveaxis(t, 2, 1)
    return t.reshape((b * d, s // d) + rest)


def from_residues(t, b, d):
    L = t.shape[1]
    rest = t.shape[2:]
    t = t.reshape((b, d, L) + rest)
    t = jnp.moveaxis(t, 1, 2)
    return t.reshape((b, L * d) + rest)


def band_attention(q, k, v, slopes, window, dilation):
    n, L, h, dh = q.shape
    nblk = -(-L // BLOCK_Q)
    lp = nblk * BLOCK_Q
    pad_end = lp - L
    qb = jnp.pad(q, ((0, 0), (0, pad_end), (0, 0), (0, 0))).reshape(n, nblk, BLOCK_Q, h, dh)

    def band(t):
        tp = jnp.pad(t, ((0, 0), (BLOCK_Q, pad_end), (0, 0), (0, 0))).reshape(n, nblk + 1, BLOCK_Q, h, dh)
        return jnp.concatenate([tp[:, :-1], tp[:, 1:]], axis=2)

    kb, vb = band(k), band(v)
    s = jnp.einsum('ncqhd,nckhd->nchqk', qb, kb, preferred_element_type=jnp.float32) * (dh ** -0.5)
    qi = jnp.arange(BLOCK_Q)[:, None]
    kj = jnp.arange(2 * BLOCK_Q)[None, :]
    dist = qi + BLOCK_Q - kj
    in_window = (dist >= 0) & (dist <= window)
    key_idx = jnp.arange(nblk)[:, None, None] * BLOCK_Q - BLOCK_Q + kj[None]
    valid = in_window[None] & (key_idx >= 0)
    bias = -(slopes[:, None, None] * (dilation * dist).astype(jnp.float32)[None])
    s = jnp.where(valid[None, :, None], s + bias[None, None], -jnp.inf)
    lse = jax.nn.logsumexp(s, axis=-1)
    p = jnp.exp(s - lse[..., None])
    o = jnp.einsum('nchqk,nckhd->ncqhd', p.astype(v.dtype), vb, preferred_element_type=jnp.float32)
    o = o.reshape(n, lp, h, dh)[:, :L]
    lse = jnp.swapaxes(lse, 2, 3).reshape(n, lp, h)[:, :L]
    return o, lse


def dilated_attention_mixer(x, w_in, w_out):
    b, s, _ = x.shape
    proj = x @ w_in
    qkv = proj[..., :QKV_WIDTH].reshape(b, s, 3, N_GROUPS, ATTN_SLOTS, HEAD_DIM)
    gate = proj[..., QKV_WIDTH:]
    slopes = jnp.asarray(alibi_slopes())
    outs, lses = [], []
    for g, (window, dil) in enumerate(DILATION_GROUPS):
        q = to_residues(qkv[:, :, 0, g], dil)
        k = to_residues(qkv[:, :, 1, g], dil)
        v = to_residues(qkv[:, :, 2, g], dil)
        o, lse = band_attention(q, k, v, slopes[g], window // dil, dil)
        outs.append(from_residues(o, b, dil))
        lses.append(from_residues(lse, b, dil))
    wts = jax.nn.softmax(jnp.stack(lses), axis=0)
    o = jnp.sum(wts[..., None] * jnp.stack(outs), axis=0)
    y = o.reshape(b, s, ATTN_WIDTH).astype(x.dtype) * jax.nn.silu(gate)
    return y @ w_out


def short_conv_mixer(x, w_in, conv_w, w_out):
    s = x.shape[1]
    proj = x @ w_in
    h, bg, cg, gate = jnp.split(proj, 4, axis=-1)
    u = cg * h
    up = jnp.pad(u, ((0, 0), (CONV_K - 1, 0), (0, 0)))
    conv = conv_w[0] * up[:, 0:s] + conv_w[1] * up[:, 1:s + 1] + conv_w[2] * up[:, 2:s + 2]
    y = bg * conv * jax.nn.silu(gate)
    return y @ w_out


def setup_inputs(seed: int = 0) -> dict:
    key = jax.random.key(seed)
    keys = jax.random.split(key, 1 + 8 * DEPTH)
    out = {"x": jax.random.normal(keys[0], (BATCH, SEQ, D_MODEL), jnp.float32)}
    ki = 1
    for i in range(DEPTH):
        kind = i % N_MIXERS
        out[f"l{i}_norm_pre"] = 1.0 + 0.1 * jax.random.normal(keys[ki], (D_MODEL,), jnp.float32); ki += 1
        if kind == 0:
            out[f"l{i}_w_in"] = jax.random.normal(keys[ki], (D_MODEL, ATTN_IN_WIDTH), jnp.float32) * D_MODEL ** -0.5; ki += 1
            out[f"l{i}_w_out"] = jax.random.normal(keys[ki], (ATTN_WIDTH, D_MODEL), jnp.float32) * ATTN_WIDTH ** -0.5; ki += 1
        else:
            out[f"l{i}_w_in"] = jax.random.normal(keys[ki], (D_MODEL, CONV_IN_WIDTH), jnp.float32) * D_MODEL ** -0.5; ki += 1
            out[f"l{i}_conv_w"] = jax.random.normal(keys[ki], (CONV_K, CONV_WIDTH), jnp.float32) * CONV_K ** -0.5; ki += 1
            out[f"l{i}_w_out"] = jax.random.normal(keys[ki], (CONV_WIDTH, D_MODEL), jnp.float32) * CONV_WIDTH ** -0.5; ki += 1
        out[f"l{i}_norm_post"] = 1.0 + 0.1 * jax.random.normal(keys[ki], (D_MODEL,), jnp.float32); ki += 1
    return out


def reference(x,
              l0_norm_pre, l0_w_in, l0_w_out, l0_norm_post,
              l1_norm_pre, l1_w_in, l1_conv_w, l1_w_out, l1_norm_post,
              l2_norm_pre, l2_w_in, l2_w_out, l2_norm_post,
              l3_norm_pre, l3_w_in, l3_conv_w, l3_w_out, l3_norm_post):
    layers = [
        (l0_norm_pre, (l0_w_in, l0_w_out), l0_norm_post),
        (l1_norm_pre, (l1_w_in, l1_conv_w, l1_w_out), l1_norm_post),
        (l2_norm_pre, (l2_w_in, l2_w_out), l2_norm_post),
        (l3_norm_pre, (l3_w_in, l3_conv_w, l3_w_out), l3_norm_post),
    ]
    for i in range(DEPTH):
        g_pre, params, g_post = layers[i]
        hN = rmsnorm(x, g_pre)
        if i % N_MIXERS == 0:
            y = dilated_attention_mixer(hN, *params)
        else:
            y = short_conv_mixer(hN, *params)
        x = x + rmsnorm(y, g_post)
    return x
```

```cpp
#include <hip/hip_runtime.h>
#include <hip/hip_cooperative_groups.h>
#include <cstdio>
#include <cstdint>
namespace cg = cooperative_groups;
namespace pg8 {
#define PG8_LAS __attribute__((address_space(3)))
typedef unsigned short bf16_t;
typedef short bf16x8 __attribute__((ext_vector_type(8)));
typedef float f32x4 __attribute__((ext_vector_type(4)));
typedef unsigned u32x4 __attribute__((ext_vector_type(4)));
constexpr int BM = 256, BK = 64, HALF = 128, HTB = HALF * BK * 2  , STAGE_BYTES = 8 * HTB, NXCD = 8, WGM = 8;

__host__ __device__ __forceinline__ int lds_byte(int r, int c) { const int st = (r >> 4) * 2 + (c >> 5), rr = r & 15, cc = c & 31, ob = rr * 64 + cc * 2; return st * 1024 + (ob ^ (((ob >> 9) & 1) << 5)); }
__host__ __device__ __forceinline__ void stage_rc(int b, int& R, int& C) { const int st = b / 1024, sb = b % 1024, swz = sb ^ (((sb >> 9) & 1) << 5); R = (st >> 1) * 16 + swz / 64; C = (st & 1) * 32 + (swz % 64) / 2; }
__host__ __device__ __forceinline__ int perm32(int rho) { const int n = rho >> 4, i = rho & 15; return 8 * (i >> 2) + 4 * n + (i & 3); }

struct Unit { int pm, pn; };
struct Gemm { const bf16_t* A; const bf16_t* Bt; int M, N, K; };

struct StaticOrder {
    int nM, nN, nwg, G, c;
    __host__ __device__ void init(int M, int N, int G_, int c_) { nM = M / BM; nN = N / BM; nwg = nM * nN; G = G_; c = c_; }
    __host__ __device__ bool next(int i, Unit& u) const {
        const long L = (long)i * G + c; if (L >= nwg) return false;
        int wgid = (int)L; { const int q = nwg / NXCD, r = nwg % NXCD, xcd = wgid % NXCD, off = wgid / NXCD; wgid = (xcd < r ? xcd * (q + 1) : r * (q + 1) + (xcd - r) * q) + off; }
        const int nig = WGM * nN, gid = wgid / nig, fm = gid * WGM, gsz = (nM - fm) < WGM ? (nM - fm) : WGM;
        u.pm = fm + ((wgid % nig) % gsz); u.pn = (wgid % nig) / gsz; return true;
    }
    __device__ __forceinline__ void a_ready(const Unit&) const {}
    __device__ __forceinline__ void done(const Unit&) const {}
};
__device__ __forceinline__ unsigned cvt_pk_bf16(float lo, float hi) { unsigned r; asm volatile("v_cvt_pk_bf16_f32 %0, %1, %2" : "=v"(r) : "v"(lo), "v"(hi)); return r; }
typedef unsigned u32x2 __attribute__((ext_vector_type(2)));
__device__ __forceinline__ float silu_f(float g) { return g * __builtin_amdgcn_rcpf(1.0f + __builtin_amdgcn_exp2f(-1.4426950408889634f * g)); }
struct EpiBf16P {
    static constexpr bool PERM = true, AFTER_DRAIN = false;
    bf16_t* O; int ldc;
    __device__ __forceinline__ void operator()(const f32x4 (&acc)[2][2][4][2], const Unit& u, int wr, int wc, int fr, int fq) const {
        const int row0 = u.pm * BM + wr * 64 + fr; const int col0 = u.pn * BM + wc * 32 + 8 * fq;
#pragma unroll
        for (int ai = 0; ai < 2; ++ai)
#pragma unroll
            for (int m = 0; m < 4; ++m) { bf16_t* rowp = O + (size_t)(row0 + ai * HALF + m * 16) * ldc + col0;
#pragma unroll
                for (int bj = 0; bj < 2; ++bj) { const f32x4 v0 = acc[ai][bj][m][0], v1 = acc[ai][bj][m][1];
                    u32x4 w; w.x = cvt_pk_bf16(v0[0], v0[1]); w.y = cvt_pk_bf16(v0[2], v0[3]); w.z = cvt_pk_bf16(v1[0], v1[1]); w.w = cvt_pk_bf16(v1[2], v1[3]);
                    *(u32x4*)(rowp + bj * HALF) = w; } }
    }
};
struct EpiF32P {
    static constexpr bool PERM = false, AFTER_DRAIN = false;
    float* C; int ldc;
    __device__ __forceinline__ void operator()(const f32x4 (&acc)[2][2][4][2], const Unit& u, int wr, int wc, int fr, int fq) const {
        const int row0 = u.pm * BM + wr * 64 + fr, col0 = u.pn * BM + wc * 32 + 4 * fq;
#pragma unroll
        for (int ai = 0; ai < 2; ++ai)
#pragma unroll
            for (int m = 0; m < 4; ++m) { float* rowp = C + (size_t)(row0 + ai * HALF + m * 16) * ldc + col0;
#pragma unroll
                for (int bj = 0; bj < 2; ++bj)
#pragma unroll
                    for (int n = 0; n < 2; ++n) *(f32x4*)(rowp + bj * HALF + n * 16) = acc[ai][bj][m][n]; }
    }
};
struct EpiConv {
    static constexpr bool PERM = false, AFTER_DRAIN = false;
    bf16_t* U; bf16_t* VG; int ldc;
    __device__ __forceinline__ void operator()(const f32x4 (&acc)[2][2][4][2], const Unit& u, int wr, int wc, int fr, int fq) const {
        const int row0 = u.pm * BM + wr * 64 + fr, ch0 = u.pn * 64 + wc * 16 + 4 * fq;
#pragma unroll
        for (int ai = 0; ai < 2; ++ai)
#pragma unroll
            for (int m = 0; m < 4; ++m) { const size_t off = (size_t)(row0 + ai * HALF + m * 16) * ldc + ch0;
                const f32x4 hh = acc[ai][0][m][0], bb = acc[ai][0][m][1], cc = acc[ai][1][m][0], gg = acc[ai][1][m][1];
                f32x4 uu = cc * hh, vv;
#pragma unroll
                for (int j = 0; j < 4; ++j) vv[j] = bb[j] * silu_f(gg[j]);
                u32x2 a, b; a.x = cvt_pk_bf16(uu[0], uu[1]); a.y = cvt_pk_bf16(uu[2], uu[3]); b.x = cvt_pk_bf16(vv[0], vv[1]); b.y = cvt_pk_bf16(vv[2], vv[3]);
                *(u32x2*)(U + off) = a; *(u32x2*)(VG + off) = b; }
    }
};
template <class Epi, class Sched, bool ALIGN_EPI = false, bool SP2 = false>
__device__ __forceinline__ void gemm_phase(PG8_LAS unsigned char* lds, const Gemm g, const Sched& S, const Epi& E) {
    int tid_ = threadIdx.x; asm volatile("" : "+v"(tid_));
    const int tid = tid_, wid = __builtin_amdgcn_readfirstlane(tid >> 6), lane = tid & 63, wr = wid >> 2, wc = wid & 3, fr = lane & 15, fq = lane >> 4;
    const int K = g.K, nt = K / BK;
    unsigned voffA[2], voffB[2];
#pragma unroll
    for (int i = 0; i < 2; ++i) { int R, C; stage_rc(tid * 16 + i * 8192, R, C); const int Rb = Epi::PERM ? ((R & ~31) + perm32(R & 31)) : R;
        voffA[i] = (unsigned)(R * K + C) * 2u; voffB[i] = (unsigned)(Rb * K + C) * 2u; }
    const size_t kstep = (size_t)(BK * 2);
    const size_t hstep = (size_t)HALF * K * 2;
    const size_t tstep = 2 * hstep;
    const unsigned ldsw = (unsigned)wid * 1024u;
    const int aoff = lds_byte(wr * 64 + fr, fq * 8), boff = lds_byte(wc * 32 + fr, fq * 8);
#define PG8_SA(b, h) (((b) * 2 + (h)) * HTB)
#define PG8_SB(b, h) ((4 + (b) * 2 + (h)) * HTB)
#define PG8_STAGE(bufoff, gbase, voff) do { _Pragma("unroll") for (int _i = 0; _i < 2; ++_i) \
        __builtin_amdgcn_global_load_lds((const unsigned*)((const char*)(gbase) + (voff)[_i]), (PG8_LAS unsigned*)(lds + (bufoff) + ldsw + _i * 8192), 16, 0, 0); } while (0)
#define PG8_LDA(dst, b, h) do { _Pragma("unroll") for (int m = 0; m < 4; ++m) _Pragma("unroll") for (int k = 0; k < 2; ++k) dst[m][k] = *(const PG8_LAS bf16x8*)(lds + PG8_SA(b, h) + aoff + m * 2048 + k * 1024); } while (0)
#define PG8_LDB(dst, b, h) do { _Pragma("unroll") for (int n = 0; n < 2; ++n) _Pragma("unroll") for (int k = 0; k < 2; ++k) dst[n][k] = *(const PG8_LAS bf16x8*)(lds + PG8_SB(b, h) + boff + n * 2048 + k * 1024); } while (0)
#define PG8_MMA(ai, bj, At, Bt) do { __builtin_amdgcn_s_setprio(1); _Pragma("unroll") for (int m = 0; m < 4; ++m) _Pragma("unroll") for (int n = 0; n < 2; ++n) _Pragma("unroll") for (int k = 0; k < 2; ++k) \
        acc[ai][bj][m][n] = __builtin_amdgcn_mfma_f32_16x16x32_bf16(Bt[n][k], At[m][k], acc[ai][bj][m][n], 0, 0, 0); __builtin_amdgcn_s_setprio(0); } while (0)
#define PG8_WAIT_V(n) asm volatile("s_waitcnt vmcnt(" #n ")" ::: "memory")
#define PG8_WAIT_L(n) asm volatile("s_waitcnt lgkmcnt(" #n ")" ::: "memory")
#define PG8_BAR __builtin_amdgcn_s_barrier()
#define PG8_SCHED __builtin_amdgcn_sched_barrier(0)
    Unit cur, nxt; int ui = 0;
    if (!S.next(0, cur)) return;
    f32x4 acc[2][2][4][2];
#pragma unroll
    for (int a = 0; a < 2; ++a)
#pragma unroll
        for (int b = 0; b < 2; ++b)
#pragma unroll
            for (int m = 0; m < 4; ++m)
#pragma unroll
                for (int n = 0; n < 2; ++n) acc[a][b][m][n] = (f32x4){0.f, 0.f, 0.f, 0.f};
    bf16x8 At[4][2], B0[2][2], B1[2][2];
    const char* cA = (const char*)g.A + (size_t)cur.pm * tstep; const char* cB = (const char*)g.Bt + (size_t)cur.pn * tstep;
    S.a_ready(cur);
    if constexpr (SP2) {
        PG8_STAGE(PG8_SB(0, 0), cB, voffB); PG8_STAGE(PG8_SB(0, 1), cB + hstep, voffB); PG8_STAGE(PG8_SA(0, 0), cA, voffA); PG8_STAGE(PG8_SA(0, 1), cA + hstep, voffA);
        if (wr == 1) PG8_BAR;
        PG8_WAIT_V(2); PG8_BAR;
        PG8_STAGE(PG8_SB(1, 0), cB + kstep, voffB); PG8_STAGE(PG8_SA(1, 0), cA + kstep, voffA); PG8_STAGE(PG8_SB(1, 1), cB + hstep + kstep, voffB);
        PG8_WAIT_V(6); PG8_BAR;
    } else {
        PG8_STAGE(PG8_SB(0, 0), cB, voffB); PG8_STAGE(PG8_SA(0, 0), cA, voffA); PG8_STAGE(PG8_SB(0, 1), cB + hstep, voffB); PG8_STAGE(PG8_SA(0, 1), cA + hstep, voffA);
        if (wr == 1) PG8_BAR;
        PG8_WAIT_V(4); PG8_BAR;
        PG8_STAGE(PG8_SB(1, 0), cB + kstep, voffB); PG8_STAGE(PG8_SA(1, 0), cA + kstep, voffA); PG8_STAGE(PG8_SB(1, 1), cB + hstep + kstep, voffB);
        PG8_WAIT_V(6); PG8_BAR;
    }
    for (;;) {
        const bool has_next = S.next(ui + 1, nxt);
        const char* nA = has_next ? (const char*)g.A + (size_t)nxt.pm * tstep : cA; const char* nB = has_next ? (const char*)g.Bt + (size_t)nxt.pn * tstep : cB;
        for (int t = 0; t < nt; t += 2) {
            const bool last = (t == nt - 2);
            const char* a1 = cA + (size_t)(t + 1) * kstep;
            const char* a2 = last ? nA : cA + (size_t)(t + 2) * kstep; const char* b2 = last ? nB : cB + (size_t)(t + 2) * kstep;
            const char* a3 = a2 + kstep; const char* b3 = b2 + kstep;
            if (last && has_next) S.a_ready(nxt);
            if constexpr (SP2) {
            PG8_LDB(B0, 0, 0); PG8_LDB(B1, 0, 1); PG8_SCHED; PG8_LDA(At, 0, 0); PG8_STAGE(PG8_SA(1, 1), a1 + hstep, voffA);
            PG8_WAIT_V(8); PG8_WAIT_L(0); PG8_BAR; PG8_MMA(0, 0, At, B0); PG8_MMA(0, 1, At, B1); PG8_BAR; PG8_SCHED;
            PG8_LDA(At, 0, 1); PG8_STAGE(PG8_SB(0, 0), b2, voffB); PG8_STAGE(PG8_SB(0, 1), b2 + hstep, voffB); PG8_STAGE(PG8_SA(0, 0), a2, voffA);
            PG8_WAIT_V(8); PG8_WAIT_L(0); PG8_BAR; PG8_MMA(1, 0, At, B0); PG8_MMA(1, 1, At, B1); PG8_BAR; PG8_SCHED;
            PG8_LDB(B0, 1, 0); PG8_LDB(B1, 1, 1); PG8_SCHED; PG8_LDA(At, 1, 0); PG8_STAGE(PG8_SA(0, 1), a2 + hstep, voffA);
            PG8_WAIT_V(8); PG8_WAIT_L(0); PG8_BAR; PG8_MMA(0, 0, At, B0); PG8_MMA(0, 1, At, B1); PG8_BAR; PG8_SCHED;
            PG8_LDA(At, 1, 1); PG8_STAGE(PG8_SB(1, 0), b3, voffB); PG8_STAGE(PG8_SB(1, 1), b3 + hstep, voffB); PG8_STAGE(PG8_SA(1, 0), a3, voffA);
            PG8_WAIT_V(8); PG8_WAIT_L(0); PG8_BAR; PG8_MMA(1, 0, At, B0); PG8_MMA(1, 1, At, B1); PG8_BAR; PG8_SCHED;
            } else {
            PG8_LDB(B0, 0, 0); PG8_SCHED; PG8_LDA(At, 0, 0); PG8_STAGE(PG8_SA(1, 1), a1 + hstep, voffA);
            PG8_WAIT_L(8); PG8_BAR; PG8_WAIT_L(0); PG8_MMA(0, 0, At, B0); PG8_BAR; PG8_SCHED;
            PG8_LDB(B1, 0, 1); PG8_STAGE(PG8_SB(0, 0), b2, voffB);
            PG8_BAR; PG8_WAIT_L(0); PG8_MMA(0, 1, At, B1); PG8_BAR;
            PG8_LDA(At, 0, 1); PG8_STAGE(PG8_SA(0, 0), a2, voffA);
            PG8_BAR; PG8_WAIT_L(0); PG8_MMA(1, 0, At, B0); PG8_BAR; PG8_SCHED;
            PG8_STAGE(PG8_SB(0, 1), b2 + hstep, voffB);
            PG8_WAIT_V(6); PG8_BAR; PG8_MMA(1, 1, At, B1); PG8_BAR;
            PG8_LDB(B0, 1, 0); PG8_SCHED; PG8_LDA(At, 1, 0); PG8_STAGE(PG8_SA(0, 1), a2 + hstep, voffA);
            PG8_WAIT_L(8); PG8_BAR; PG8_WAIT_L(0); PG8_MMA(0, 0, At, B0); PG8_BAR; PG8_SCHED;
            PG8_LDB(B1, 1, 1); PG8_STAGE(PG8_SB(1, 0), b3, voffB);
            PG8_BAR; PG8_WAIT_L(0); PG8_MMA(0, 1, At, B1); PG8_BAR;
            PG8_LDA(At, 1, 1); PG8_STAGE(PG8_SA(1, 0), a3, voffA);
            PG8_BAR; PG8_WAIT_L(0); PG8_MMA(1, 0, At, B0); PG8_BAR; PG8_SCHED;
            PG8_STAGE(PG8_SB(1, 1), b3 + hstep, voffB);
            PG8_WAIT_V(6); PG8_BAR; PG8_MMA(1, 1, At, B1); PG8_BAR;
            }
        }
        if constexpr (ALIGN_EPI) { if (wr == 0) PG8_BAR; }
        if constexpr (!Epi::AFTER_DRAIN) { E(acc, cur, wr, wc, fr, fq); S.done(cur); }
        if (!has_next) break;
#pragma unroll
        for (int a = 0; a < 2; ++a)
#pragma unroll
            for (int b = 0; b < 2; ++b)
#pragma unroll
                for (int m = 0; m < 4; ++m)
#pragma unroll
                    for (int n = 0; n < 2; ++n) acc[a][b][m][n] = (f32x4){0.f, 0.f, 0.f, 0.f};
        cur = nxt; cA = nA; cB = nB; ++ui;
        if constexpr (ALIGN_EPI) { if (wr == 1) PG8_BAR; }
    }
    PG8_WAIT_V(0);
    if constexpr (!ALIGN_EPI) { if (wr == 0) PG8_BAR; }
    PG8_BAR;
    if constexpr (Epi::AFTER_DRAIN) { E.fused(acc, cur, wr, wc, fr, fq, lds, wid, lane); S.done(cur); }
#undef PG8_SA
#undef PG8_SB
#undef PG8_STAGE
#undef PG8_LDA
#undef PG8_LDB
#undef PG8_MMA
#undef PG8_WAIT_V
#undef PG8_WAIT_L
#undef PG8_BAR
#undef PG8_SCHED
}
}

#define LAS __attribute__((address_space(3)))
typedef unsigned short bf16;
typedef short bf16x8 __attribute__((ext_vector_type(8)));
typedef short s16x4 __attribute__((ext_vector_type(4)));
typedef short v4i16_t __attribute__((ext_vector_type(4)));
typedef float f32x4 __attribute__((ext_vector_type(4)));
typedef unsigned u32x4 __attribute__((ext_vector_type(4)));
typedef unsigned u32x2 __attribute__((ext_vector_type(2)));
constexpr int SEQ = 16384, DM = 2048, MTOK = 32768, NATT = 20480, NCONV = 8192, QKVW = 18432;
constexpr float NORM_EPS = 1e-6f;
constexpr int NWAVES = 8, NTHREADS = 512;
constexpr size_t MiB = 1u << 20;
constexpr size_t WS_LSE = 1 * MiB;
constexpr size_t WS_WIN = 8 * MiB;
constexpr size_t WS_WOUT = 88 * MiB;
constexpr size_t WS_HN = 96 * MiB;
constexpr size_t WS_PROJ = 224 * MiB;
constexpr size_t WS_END = 864 * MiB;
constexpr int LDS_BYTES = 131072 + 1024;

__device__ __forceinline__ float wave_sum(float v) {
#pragma unroll
    for (int o = 1; o < 64; o <<= 1) v += __shfl_xor(v, o);
    return v;
}
__device__ __forceinline__ unsigned f2bf(float f) { unsigned u = __builtin_bit_cast(unsigned, f); return (u + 0x7fffu + ((u >> 16) & 1u)) >> 16; }
__device__ __forceinline__ unsigned pk2(float lo, float hi) { return f2bf(lo) | (f2bf(hi) << 16); }
__device__ __forceinline__ float bflo(unsigned w) { return __builtin_bit_cast(float, w << 16); }
__device__ __forceinline__ float bfhi(unsigned w) { return __builtin_bit_cast(float, w & 0xffff0000u); }
#define LDS_WAIT() asm volatile("s_waitcnt lgkmcnt(0)" ::: "memory")

template <int MAP> __device__ __forceinline__ int rowmap(int sc) {
    if (MAP == 0) return sc;
    const int type = sc >> 11, ch = sc & 2047, pn = ch >> 6, cl = ch & 63;
    return 256 * pn + 128 * (type >> 1) + 32 * (cl >> 4) + 16 * (type & 1) + (cl & 15);
}
template <int MAP> __device__ __forceinline__ void transpose_item(const float* W, int K, int N, bf16* WT, LAS float* scr, int item, int lane) {
    const int nblk = N / 32, kb = item / nblk, nb = item % nblk, k0 = 64 * kb, n0 = 32 * nb;
#pragma unroll 8
    for (int i = 0; i < 32; ++i) { const int kk = 2 * i + (lane >> 5); scr[kk * 33 + (lane & 31)] = W[(size_t)(k0 + kk) * N + n0 + (lane & 31)]; }
    LDS_WAIT(); asm volatile("" ::: "memory");
    const int c = lane & 7;
#pragma unroll
    for (int j = 0; j < 4; ++j) { const int n = (lane >> 3) + 8 * j; const LAS float* s = scr + (8 * c) * 33 + n;
        u32x4 o; o.x = pk2(s[0 * 33], s[1 * 33]); o.y = pk2(s[2 * 33], s[3 * 33]); o.z = pk2(s[4 * 33], s[5 * 33]); o.w = pk2(s[6 * 33], s[7 * 33]);
        *(u32x4*)(WT + (size_t)rowmap<MAP>(n0 + n) * K + k0 + 8 * c) = o; }
    LDS_WAIT(); asm volatile("" ::: "memory");
}

template <int MODE> __device__ __forceinline__ void norm_rows(const float* xs, const float* y2, float* out, bf16* hn, const float* gpost, const float* gpre, int gw, int ngw, int lane) {
    f32x4 gp[8], gq[8];
#pragma unroll
    for (int j = 0; j < 8; ++j) { if (MODE != 0) gp[j] = ((const f32x4*)gpost)[lane + 64 * j]; if (MODE != 2) gq[j] = ((const f32x4*)gpre)[lane + 64 * j]; }
    for (int m = gw; m < MTOK; m += ngw) {
        f32x4 v[8]; const f32x4* xr = (const f32x4*)(xs + (size_t)m * DM) + lane;
#pragma unroll
        for (int j = 0; j < 8; ++j) v[j] = xr[64 * j];
        if (MODE != 0) {
            f32x4 y[8]; const f32x4* yr = (const f32x4*)(y2 + (size_t)m * DM) + lane; float ss = 0.f;
#pragma unroll
            for (int j = 0; j < 8; ++j) { y[j] = yr[64 * j]; ss += (y[j].x * y[j].x + y[j].y * y[j].y) + (y[j].z * y[j].z + y[j].w * y[j].w); }
            const float rs = 1.0f / sqrtf(wave_sum(ss) * (1.0f / DM) + NORM_EPS);
            f32x4* orow = (f32x4*)(out + (size_t)m * DM) + lane;
#pragma unroll
            for (int j = 0; j < 8; ++j) { v[j] = v[j] + y[j] * rs * gp[j]; orow[64 * j] = v[j]; }
        }
        if (MODE != 2) {
            float ss = 0.f;
#pragma unroll
            for (int j = 0; j < 8; ++j) ss += (v[j].x * v[j].x + v[j].y * v[j].y) + (v[j].z * v[j].z + v[j].w * v[j].w);
            const float rs = 1.0f / sqrtf(wave_sum(ss) * (1.0f / DM) + NORM_EPS);
            u32x2* o8 = (u32x2*)(hn + (size_t)m * DM) + lane;
#pragma unroll
            for (int j = 0; j < 8; ++j) { const f32x4 t = v[j] * rs * gq[j]; u32x2 w; w.x = pk2(t.x, t.y); w.y = pk2(t.z, t.w); o8[64 * j] = w; }
        }
    }
}

__device__ __forceinline__ void conv_phase(const bf16* U, const bf16* VG, const float* cw, bf16* Y, int gtid, int nthr) {
    for (int item = gtid; item < 256 * (MTOK / 32); item += nthr) {
        const int chunk = item & 255, run = item >> 8, ch0 = chunk * 8, row0 = run * 32;
        float w0[8], w1[8], w2[8], um1[8], um2[8];
#pragma unroll
        for (int j = 0; j < 8; ++j) { w0[j] = cw[ch0 + j]; w1[j] = cw[DM + ch0 + j]; w2[j] = cw[2 * DM + ch0 + j]; um1[j] = 0.f; um2[j] = 0.f; }
        if ((row0 & (SEQ - 1)) != 0) {
            const u32x4 a = *(const u32x4*)(U + (size_t)(row0 - 1) * DM + ch0), b = *(const u32x4*)(U + (size_t)(row0 - 2) * DM + ch0);
#pragma unroll
            for (int j = 0; j < 4; ++j) { um1[2 * j] = bflo(a[j]); um1[2 * j + 1] = bfhi(a[j]); um2[2 * j] = bflo(b[j]); um2[2 * j + 1] = bfhi(b[j]); }
        }
#pragma unroll 8
        for (int i = 0; i < 32; ++i) {
            const size_t off = (size_t)(row0 + i) * DM + ch0;
            const u32x4 uu = *(const u32x4*)(U + off), vv = *(const u32x4*)(VG + off); u32x4 o;
#pragma unroll
            for (int j = 0; j < 4; ++j) {
                const float u0 = bflo(uu[j]), u1 = bfhi(uu[j]);
                const float y0 = bflo(vv[j]) * (w0[2 * j] * um2[2 * j] + w1[2 * j] * um1[2 * j] + w2[2 * j] * u0);
                const float y1 = bfhi(vv[j]) * (w0[2 * j + 1] * um2[2 * j + 1] + w1[2 * j + 1] * um1[2 * j + 1] + w2[2 * j + 1] * u1);
                o[j] = pk2(y0, y1); um2[2 * j] = um1[2 * j]; um2[2 * j + 1] = um1[2 * j + 1]; um1[2 * j] = u0; um1[2 * j + 1] = u1;
            }
            *(u32x4*)(Y + off) = o;
        }
    }
}

__device__ __forceinline__ s16x4 vtr(const LAS unsigned char* p) { return __builtin_bit_cast(s16x4, __builtin_amdgcn_ds_read_tr16_b64_v4i16((LAS v4i16_t*)p)); }
struct AttnPre { u32x4 k[8]; bf16x8 q[4]; };
__device__ __forceinline__ void attn_decode(int U, int gbase, int& g, int& h, int& r, int& c, int& d) {
    const int gh = U >> 7, uid = U & 127; g = gbase + (gh >> 4); h = gh & 15;
    d = (g == 0) ? 1 : (g == 1 ? 4 : 16); const int nblk = 128 / d; r = uid / nblk; c = uid % nblk;
}
__device__ __forceinline__ void attn_load_rows(u32x4 (&dst)[8], const bf16* proj, int col0, int r, int c, int d, int tid) {
    const int chunk = tid & 15;
#pragma unroll
    for (int p = 0; p < 8; ++p) {
        const int j = p * 32 + (tid >> 4), u = 128 * c - 128 + j;
        if (u >= 0) dst[p] = *(const u32x4*)(proj + (size_t)(u * d + r) * NATT + col0 + chunk * 8);
        else dst[p] = (u32x4){0u, 0u, 0u, 0u};
    }
}
__device__ __forceinline__ void attn_prefetch(AttnPre& P, const bf16* proj, int g, int h, int r, int c, int d, int tid, int wave, int lane) {
    attn_load_rows(P.k, proj, ((3 + g) * 16 + h) * 128, r, c, d, tid);
    const size_t qrow = (size_t)((128 * c + 16 * wave + (lane & 15)) * d + r) * NATT + (g * 16 + h) * 128 + 8 * (lane >> 4);
#pragma unroll
    for (int kk = 0; kk < 4; ++kk) P.q[kk] = *(const bf16x8*)(proj + qrow + 32 * kk);
}
template <bool MERGE> __device__ __forceinline__ void attn_phase(LAS unsigned char* lds, bf16* proj, float* lse, bf16* Y, int gbase, int nunits, int vcu, int G) {
    int tid_ = threadIdx.x; asm volatile("" : "+v"(tid_));
    const int tid = tid_, lane = tid & 63, wave = __builtin_amdgcn_readfirstlane(tid >> 6), l15 = lane & 15, fg = lane >> 4, r4 = (lane & 15) >> 2, cc = lane & 3;
    LAS unsigned char* Kl = lds; LAS unsigned char* Vl = lds + 65536;
    int U = vcu; if (U >= nunits) return;
    int g, h, r, c, d; attn_decode(U, gbase, g, h, r, c, d);
    AttnPre P; attn_prefetch(P, proj, g, h, r, c, d, tid, wave, lane);
    const int x7 = 4 * (fg & 1) + r4;
    const int jrow = tid >> 4, chunk = tid & 15;
    const int kwoff = jrow * 256 + ((chunk ^ (jrow & 15)) << 4), vwoff = jrow * 256 + (((((chunk >> 1) ^ (jrow & 7)) << 1) | (chunk & 1)) << 4);
    const LAS unsigned char* kbase = Kl + (16 * wave + l15) * 256;
    int kx[4];
#pragma unroll
    for (int kk = 0; kk < 4; ++kk) kx[kk] = ((4 * kk + fg) ^ l15) << 4;
    const LAS unsigned char* vbase = Vl + (16 * wave + 4 * fg + r4) * 256 + 8 * cc;
    for (;;) {
#pragma unroll
        for (int p = 0; p < 8; ++p) *(LAS u32x4*)(Kl + kwoff + p * 8192) = P.k[p];
        u32x4 vreg[8];
        attn_load_rows(vreg, proj, ((6 + g) * 16 + h) * 128, r, c, d, tid);
        bf16x8 q[4];
#pragma unroll
        for (int kk = 0; kk < 4; ++kk) q[kk] = P.q[kk];
        const int cg = g, ch = h, cr = r, cb = c, cd = d;
        __syncthreads();
        f32x4 sacc[9];
#pragma unroll
        for (int tt = 0; tt < 9; ++tt) { sacc[tt] = (f32x4){0.f, 0.f, 0.f, 0.f};
#pragma unroll
            for (int kk = 0; kk < 4; ++kk) { const bf16x8 kf = *(const LAS bf16x8*)(kbase + tt * 4096 + kx[kk]); sacc[tt] = __builtin_amdgcn_mfma_f32_16x16x32_bf16(kf, q[kk], sacc[tt], 0, 0, 0); } }
        const float slope = __builtin_amdgcn_exp2f(-8.0f * (float)(cg * 16 + ch + 1) / 48.0f);
        const float sc2 = 0.08838834764831845f * 1.4426950408889634f, sl2 = slope * (float)cd * 1.4426950408889634f;
        float mx = -3.0e38f;
#pragma unroll
        for (int tt = 0; tt < 9; ++tt)
#pragma unroll
            for (int e = 0; e < 4; ++e) {
                const int dist = 128 + l15 - 16 * tt - 4 * fg - e, kj = 16 * (wave + tt) + 4 * fg + e;
                const bool valid = (dist >= 0) && (dist <= 128) && (cb > 0 || kj >= 128);
                const float s = valid ? (sacc[tt][e] * sc2 - sl2 * (float)dist) : -3.0e38f;
                sacc[tt][e] = s; mx = fmaxf(mx, s);
            }
        mx = fmaxf(mx, __shfl_xor(mx, 16)); mx = fmaxf(mx, __shfl_xor(mx, 32));
        float sum = 0.f; bf16x8 pf[5];
#pragma unroll
        for (int pp = 0; pp < 5; ++pp) {
            float p0[4], p1[4];
#pragma unroll
            for (int e = 0; e < 4; ++e) { p0[e] = __builtin_amdgcn_exp2f(sacc[2 * pp][e] - mx); p1[e] = (pp < 4) ? __builtin_amdgcn_exp2f(sacc[(pp < 4) ? 2 * pp + 1 : 0][e] - mx) : 0.f; sum += p0[e] + p1[e]; }
            u32x4 w; w.x = pk2(p0[0], p0[1]); w.y = pk2(p0[2], p0[3]); w.z = pk2(p1[0], p1[1]); w.w = pk2(p1[2], p1[3]);
            pf[pp] = __builtin_bit_cast(bf16x8, w);
        }
        sum += __shfl_xor(sum, 16); sum += __shfl_xor(sum, 32);
#pragma unroll
        for (int p = 0; p < 8; ++p) *(LAS u32x4*)(Vl + vwoff + p * 8192) = vreg[p];
        __syncthreads();
        const int Un = U + G; const bool has_next = Un < nunits;
        if (has_next) { attn_decode(Un, gbase, g, h, r, c, d); attn_prefetch(P, proj, g, h, r, c, d, tid, wave, lane); }
        f32x4 oacc[8];
#pragma unroll
        for (int c8 = 0; c8 < 8; ++c8) oacc[c8] = (f32x4){0.f, 0.f, 0.f, 0.f};
#pragma unroll
        for (int pp = 0; pp < 5; ++pp) {
#pragma unroll
            for (int c8 = 0; c8 < 8; ++c8) {
                const LAS unsigned char* vp = vbase + ((c8 ^ x7) << 5);
                const s16x4 a0 = vtr(vp + (2 * pp) * 4096);
                s16x4 a1 = (s16x4){0, 0, 0, 0}; if (pp < 4) a1 = vtr(vp + (2 * pp + 1) * 4096);
                bf16x8 a; a[0] = a0[0]; a[1] = a0[1]; a[2] = a0[2]; a[3] = a0[3]; a[4] = a1[0]; a[5] = a1[1]; a[6] = a1[2]; a[7] = a1[3];
                oacc[c8] = __builtin_amdgcn_mfma_f32_16x16x32_bf16(a, pf[pp], oacc[c8], 0, 0, 0);
            }
        }
        const int tok = (128 * cb + 16 * wave + l15) * cd + cr;
        const float lse2 = mx + __builtin_amdgcn_logf(sum);
        if (!MERGE) {
            const float inv = 1.0f / sum;
            bf16* orow = proj + (size_t)tok * NATT + (cg * 16 + ch) * 128 + 4 * fg;
#pragma unroll
            for (int c8 = 0; c8 < 8; ++c8) { u32x2 w; w.x = pk2(oacc[c8][0] * inv, oacc[c8][1] * inv); w.y = pk2(oacc[c8][2] * inv, oacc[c8][3] * inv); *(u32x2*)(orow + 16 * c8) = w; }
            if (fg == 0) lse[((size_t)(cg - 1) * SEQ + tok) * 16 + ch] = lse2;
        } else {
            const float l1 = lse[((size_t)0 * SEQ + tok) * 16 + ch], l2 = lse[((size_t)1 * SEQ + tok) * 16 + ch];
            const float mm = fmaxf(lse2, fmaxf(l1, l2));
            const float w0 = __builtin_amdgcn_exp2f(lse2 - mm), w1 = __builtin_amdgcn_exp2f(l1 - mm), w2 = __builtin_amdgcn_exp2f(l2 - mm);
            const float inv = 1.0f / (w0 + w1 + w2), k0 = w0 * inv / sum, k1 = w1 * inv, k2 = w2 * inv;
            const bf16* prow = proj + (size_t)tok * NATT + 4 * fg;
            bf16* yrow = Y + (size_t)tok * DM + ch * 128 + 4 * fg;
#pragma unroll
            for (int c8 = 0; c8 < 8; ++c8) {
                const u32x2 o1 = *(const u32x2*)(prow + (16 + ch) * 128 + 16 * c8), o2 = *(const u32x2*)(prow + (32 + ch) * 128 + 16 * c8), gt = *(const u32x2*)(prow + QKVW + ch * 128 + 16 * c8);
                float y[4];
                y[0] = oacc[c8][0] * k0 + bflo(o1.x) * k1 + bflo(o2.x) * k2; y[1] = oacc[c8][1] * k0 + bfhi(o1.x) * k1 + bfhi(o2.x) * k2;
                y[2] = oacc[c8][2] * k0 + bflo(o1.y) * k1 + bflo(o2.y) * k2; y[3] = oacc[c8][3] * k0 + bfhi(o1.y) * k1 + bfhi(o2.y) * k2;
                y[0] *= pg8::silu_f(bflo(gt.x)); y[1] *= pg8::silu_f(bfhi(gt.x)); y[2] *= pg8::silu_f(bflo(gt.y)); y[3] *= pg8::silu_f(bfhi(gt.y));
                u32x2 w; w.x = pk2(y[0], y[1]); w.y = pk2(y[2], y[3]); *(u32x2*)(yrow + 16 * c8) = w;
            }
        }
        if (!has_next) break;
        U = Un;
    }
    __syncthreads();
}

struct Args { const float* in[19]; float* out; unsigned char* ws; };
__global__ void __launch_bounds__(NTHREADS, 2) mega_fwd(Args a) {
    extern __shared__ __attribute__((aligned(16))) unsigned char lds_raw[];
    cg::grid_group grid = cg::this_grid();
    LAS unsigned char* lds = (LAS unsigned char*)lds_raw;
    const int G = gridDim.x, bx = blockIdx.x;
    const int vcu = (G % 8 == 0) ? (bx % 8) * (G / 8) + bx / 8 : bx;
    const int ngw = G * NWAVES;
    unsigned char* ws = a.ws;
    bf16* WIN = (bf16*)(ws + WS_WIN); bf16* WOUT = (bf16*)(ws + WS_WOUT); bf16* HN = (bf16*)(ws + WS_HN); bf16* PROJ = (bf16*)(ws + WS_PROJ);
    float* LSE = (float*)(ws + WS_LSE); float* Y2 = (float*)(ws + WS_PROJ);

#pragma nounroll
    for (int layer = 0; layer < 4; ++layer) {
        const bool is_attn = (layer & 1) == 0;
        const int base = 1 + 9 * (layer >> 1) + (is_attn ? 0 : 4);
        const float* g_pre = a.in[base]; const float* w_in = a.in[base + 1];
        const float* conv_w = a.in[base + 2];
        const float* w_out = a.in[base + (is_attn ? 2 : 3)];
        const float* g_post_prev = a.in[layer == 0 ? 4 : (layer == 1 ? 4 : (layer == 2 ? 9 : 13))];
        int tid_ = threadIdx.x; asm volatile("" : "+v"(tid_));
        const int tid = tid_, lane = tid & 63, wave = __builtin_amdgcn_readfirstlane(tid >> 6), gw = bx * NWAVES + wave;
        LAS float* scr = (LAS float*)(lds + wave * 16384);
        if (is_attn) { const int items_in = (DM / 64) * (NATT / 32);
            for (int it = gw; it < items_in; it += ngw) transpose_item<0>(w_in, DM, NATT, WIN, scr, it, lane);
        } else { const int items_in = (DM / 64) * (NCONV / 32);
            for (int it = gw; it < items_in; it += ngw) transpose_item<1>(w_in, DM, NCONV, WIN, scr, it, lane);
        }
        { const int items_out = (DM / 64) * (DM / 32);
            for (int it = gw; it < items_out; it += ngw) transpose_item<0>(w_out, DM, DM, WOUT, scr, it, lane); }
        if (layer == 0) norm_rows<0>(a.in[0], nullptr, nullptr, HN, nullptr, g_pre, gw, ngw, lane);
        else norm_rows<1>(layer == 1 ? a.in[0] : a.out, Y2, a.out, HN, g_post_prev, g_pre, gw, ngw, lane);
        grid.sync();
        if (is_attn) {
#pragma nounroll
            for (int half = 0; half < 2; ++half) {
                { pg8::Gemm g{HN + (size_t)half * SEQ * DM, WIN, SEQ, NATT, DM}; pg8::StaticOrder So; So.init(SEQ, NATT, G, bx);
                  pg8::EpiBf16P E{PROJ, NATT};
                  pg8::gemm_phase<pg8::EpiBf16P, pg8::StaticOrder, true, true>(lds, g, So, E); }
                grid.sync();
                attn_phase<false>(lds, PROJ, LSE, nullptr, 1, 2 * 16 * 128, vcu, G);
                grid.sync();
                attn_phase<true>(lds, PROJ, LSE, HN + (size_t)half * SEQ * DM, 0, 16 * 128, vcu, G);
                grid.sync();
            }
        } else {
            { pg8::Gemm g{HN, WIN, MTOK, NCONV, DM}; pg8::StaticOrder So; So.init(MTOK, NCONV, G, bx);
              pg8::EpiConv E{PROJ, PROJ + (size_t)MTOK * DM, DM};
              pg8::gemm_phase<pg8::EpiConv, pg8::StaticOrder, true, true>(lds, g, So, E); }
            grid.sync();
            { int t2 = threadIdx.x; asm volatile("" : "+v"(t2)); conv_phase(PROJ, PROJ + (size_t)MTOK * DM, conv_w, HN, bx * NTHREADS + t2, G * NTHREADS); }
            grid.sync();
        }
        { pg8::Gemm g{HN, WOUT, MTOK, DM, DM}; pg8::StaticOrder So; So.init(MTOK, DM, G, bx);
          pg8::EpiF32P E{Y2, DM};
          pg8::gemm_phase<pg8::EpiF32P, pg8::StaticOrder, true, true>(lds, g, So, E); }
        grid.sync();
    }
    { int t3 = threadIdx.x; asm volatile("" : "+v"(t3)); const int wave3 = __builtin_amdgcn_readfirstlane(t3 >> 6);
      norm_rows<2>(a.out, Y2, a.out, nullptr, a.in[18], nullptr, bx * NWAVES + wave3, ngw, t3 & 63); }
}

extern "C" void kernel_launch(void* const* d_in, const int* in_sizes, int n_in, void* d_out, int out_size, void* d_ws, size_t ws_size, hipStream_t stream) {
    static int grid = 0;
    if (grid == 0) {
        if (n_in != 19 || ws_size < WS_END) { fprintf(stderr, "kernel_launch: unexpected n_in %d or ws_size %zu (need %zu)\n", n_in, ws_size, (size_t)WS_END); grid = -1; return; }
        int dev = 0, cus = 0, per_cu = 0;
        hipGetDevice(&dev); hipDeviceGetAttribute(&cus, hipDeviceAttributeMultiprocessorCount, dev);
        if (hipFuncSetAttribute((const void*)mega_fwd, hipFuncAttributeMaxDynamicSharedMemorySize, LDS_BYTES) != hipSuccess) { fprintf(stderr, "kernel_launch: hipFuncSetAttribute failed\n"); grid = -1; return; }
        if (hipOccupancyMaxActiveBlocksPerMultiprocessor(&per_cu, (const void*)mega_fwd, NTHREADS, LDS_BYTES) != hipSuccess || per_cu < 1) { fprintf(stderr, "kernel_launch: occupancy query gave %d\n", per_cu); per_cu = 1; }
        (void)hipGetLastError();
        grid = cus * 1;
    }
    if (grid < 0) return;
    Args a{};
    for (int i = 0; i < 19; ++i) a.in[i] = (const float*)d_in[i];
    a.out = (float*)d_out; a.ws = (unsigned char*)d_ws;
    void* args[] = {&a};
    hipError_t e = hipLaunchCooperativeKernel((const void*)mega_fwd, dim3(grid), dim3(NTHREADS), args, LDS_BYTES, stream);
    if (e != hipSuccess) fprintf(stderr, "cooperative launch failed: %s (grid %d)\n", hipGetErrorString(e), grid);
}
```

```cpp
#include <hip/hip_runtime.h>
#include <hip/hip_cooperative_groups.h>
#include <cstdio>
#include <cstdint>
namespace cg = cooperative_groups;
namespace pg8 {
#define PG8_LAS __attribute__((address_space(3)))
typedef unsigned short bf16_t;
typedef short bf16x8 __attribute__((ext_vector_type(8)));
typedef float f32x4 __attribute__((ext_vector_type(4)));
typedef unsigned u32x4 __attribute__((ext_vector_type(4)));
constexpr int BM = 256, BK = 64, HALF = 128, HTB = HALF * BK * 2  , STAGE_BYTES = 8 * HTB, NXCD = 8, WGM = 8;

__host__ __device__ __forceinline__ int lds_byte(int r, int c) { const int st = (r >> 4) * 2 + (c >> 5), rr = r & 15, cc = c & 31, ob = rr * 64 + cc * 2; return st * 1024 + (ob ^ (((ob >> 9) & 1) << 5)); }
__host__ __device__ __forceinline__ void stage_rc(int b, int& R, int& C) { const int st = b / 1024, sb = b % 1024, swz = sb ^ (((sb >> 9) & 1) << 5); R = (st >> 1) * 16 + swz / 64; C = (st & 1) * 32 + (swz % 64) / 2; }
__host__ __device__ __forceinline__ int perm32(int rho) { const int n = rho >> 4, i = rho & 15; return 8 * (i >> 2) + 4 * n + (i & 3); }

struct Unit { int pm, pn; };
struct Gemm { const bf16_t* A; const bf16_t* Bt; int M, N, K; };

struct StaticOrder {
    int nM, nN, nwg, G, c;
    __host__ __device__ void init(int M, int N, int G_, int c_) { nM = M / BM; nN = N / BM; nwg = nM * nN; G = G_; c = c_; }
    __host__ __device__ bool next(int i, Unit& u) const {
        const long L = (long)i * G + c; if (L >= nwg) return false;
        int wgid = (int)L; { const int q = nwg / NXCD, r = nwg % NXCD, xcd = wgid % NXCD, off = wgid / NXCD; wgid = (xcd < r ? xcd * (q + 1) : r * (q + 1) + (xcd - r) * q) + off; }
        const int nig = WGM * nN, gid = wgid / nig, fm = gid * WGM, gsz = (nM - fm) < WGM ? (nM - fm) : WGM;
        u.pm = fm + ((wgid % nig) % gsz); u.pn = (wgid % nig) / gsz; return true;
    }
    __device__ __forceinline__ void a_ready(const Unit&) const {}
    __device__ __forceinline__ void done(const Unit&) const {}
};
__device__ __forceinline__ unsigned cvt_pk_bf16(float lo, float hi) { unsigned r; asm volatile("v_cvt_pk_bf16_f32 %0, %1, %2" : "=v"(r) : "v"(lo), "v"(hi)); return r; }
typedef unsigned u32x2 __attribute__((ext_vector_type(2)));
__device__ __forceinline__ float silu_f(float g) { return g * __builtin_amdgcn_rcpf(1.0f + __builtin_amdgcn_exp2f(-1.4426950408889634f * g)); }
struct EpiBf16P {
    static constexpr bool PERM = true, AFTER_DRAIN = false;
    bf16_t* O; int ldc; const float* rs;
    __device__ __forceinline__ void operator()(const f32x4 (&acc)[2][2][4][2], const Unit& u, int wr, int wc, int fr, int fq) const {
        const int row0 = u.pm * BM + wr * 64 + fr; const int col0 = u.pn * BM + wc * 32 + 8 * fq;
#pragma unroll
        for (int ai = 0; ai < 2; ++ai)
#pragma unroll
            for (int m = 0; m < 4; ++m) { bf16_t* rowp = O + (size_t)(row0 + ai * HALF + m * 16) * ldc + col0;
                const float s = rs ? rs[row0 + ai * HALF + m * 16] : 1.0f;
#pragma unroll
                for (int bj = 0; bj < 2; ++bj) { const f32x4 v0 = acc[ai][bj][m][0] * s, v1 = acc[ai][bj][m][1] * s;
                    u32x4 w; w.x = cvt_pk_bf16(v0[0], v0[1]); w.y = cvt_pk_bf16(v0[2], v0[3]); w.z = cvt_pk_bf16(v1[0], v1[1]); w.w = cvt_pk_bf16(v1[2], v1[3]);
                    *(u32x4*)(rowp + bj * HALF) = w; } }
    }
};
struct EpiF32P {
    static constexpr bool PERM = false, AFTER_DRAIN = false;
    float* C; int ldc;
    __device__ __forceinline__ void operator()(const f32x4 (&acc)[2][2][4][2], const Unit& u, int wr, int wc, int fr, int fq) const {
        const int row0 = u.pm * BM + wr * 64 + fr, col0 = u.pn * BM + wc * 32 + 4 * fq;
#pragma unroll
        for (int ai = 0; ai < 2; ++ai)
#pragma unroll
            for (int m = 0; m < 4; ++m) { float* rowp = C + (size_t)(row0 + ai * HALF + m * 16) * ldc + col0;
#pragma unroll
                for (int bj = 0; bj < 2; ++bj)
#pragma unroll
                    for (int n = 0; n < 2; ++n) *(f32x4*)(rowp + bj * HALF + n * 16) = acc[ai][bj][m][n]; }
    }
};
struct EpiConv {
    static constexpr bool PERM = false, AFTER_DRAIN = false;
    bf16_t* U; bf16_t* VG; int ldc; const float* rs;
    __device__ __forceinline__ void operator()(const f32x4 (&acc)[2][2][4][2], const Unit& u, int wr, int wc, int fr, int fq) const {
        const int row0 = u.pm * BM + wr * 64 + fr, ch0 = u.pn * 64 + wc * 16 + 4 * fq;
#pragma unroll
        for (int ai = 0; ai < 2; ++ai)
#pragma unroll
            for (int m = 0; m < 4; ++m) { const size_t off = (size_t)(row0 + ai * HALF + m * 16) * ldc + ch0;
                const float s = rs[row0 + ai * HALF + m * 16];
                const f32x4 hh = acc[ai][0][m][0] * s, bb = acc[ai][0][m][1] * s, cc = acc[ai][1][m][0] * s, gg = acc[ai][1][m][1] * s;
                f32x4 uu = cc * hh, vv;
#pragma unroll
                for (int j = 0; j < 4; ++j) vv[j] = bb[j] * silu_f(gg[j]);
                u32x2 a, b; a.x = cvt_pk_bf16(uu[0], uu[1]); a.y = cvt_pk_bf16(uu[2], uu[3]); b.x = cvt_pk_bf16(vv[0], vv[1]); b.y = cvt_pk_bf16(vv[2], vv[3]);
                *(u32x2*)(U + off) = a; *(u32x2*)(VG + off) = b; }
    }
};
template <class Epi, class Sched, bool ALIGN_EPI = false, bool SP2 = false>
__device__ __forceinline__ void gemm_phase(PG8_LAS unsigned char* lds, const Gemm g, const Sched& S, const Epi& E) {
    int tid_ = threadIdx.x; asm volatile("" : "+v"(tid_));
    const int tid = tid_, wid = __builtin_amdgcn_readfirstlane(tid >> 6), lane = tid & 63, wr = wid >> 2, wc = wid & 3, fr = lane & 15, fq = lane >> 4;
    const int K = g.K, nt = K / BK;
    unsigned voffA[2], voffB[2];
#pragma unroll
    for (int i = 0; i < 2; ++i) { int R, C; stage_rc(tid * 16 + i * 8192, R, C); const int Rb = Epi::PERM ? ((R & ~31) + perm32(R & 31)) : R;
        voffA[i] = (unsigned)(R * K + C) * 2u; voffB[i] = (unsigned)(Rb * K + C) * 2u; }
    const size_t kstep = (size_t)(BK * 2);
    const size_t hstep = (size_t)HALF * K * 2;
    const size_t tstep = 2 * hstep;
    const unsigned ldsw = (unsigned)wid * 1024u;
    const int aoff = lds_byte(wr * 64 + fr, fq * 8), boff = lds_byte(wc * 32 + fr, fq * 8);
#define PG8_SA(b, h) (((b) * 2 + (h)) * HTB)
#define PG8_SB(b, h) ((4 + (b) * 2 + (h)) * HTB)
#define PG8_STAGE(bufoff, gbase, voff) do { _Pragma("unroll") for (int _i = 0; _i < 2; ++_i) \
        __builtin_amdgcn_global_load_lds((const unsigned*)((const char*)(gbase) + (voff)[_i]), (PG8_LAS unsigned*)(lds + (bufoff) + ldsw + _i * 8192), 16, 0, 0); } while (0)
#define PG8_LDA(dst, b, h) do { _Pragma("unroll") for (int m = 0; m < 4; ++m) _Pragma("unroll") for (int k = 0; k < 2; ++k) dst[m][k] = *(const PG8_LAS bf16x8*)(lds + PG8_SA(b, h) + aoff + m * 2048 + k * 1024); } while (0)
#define PG8_LDB(dst, b, h) do { _Pragma("unroll") for (int n = 0; n < 2; ++n) _Pragma("unroll") for (int k = 0; k < 2; ++k) dst[n][k] = *(const PG8_LAS bf16x8*)(lds + PG8_SB(b, h) + boff + n * 2048 + k * 1024); } while (0)
#define PG8_MMA(ai, bj, At, Bt) do { __builtin_amdgcn_s_setprio(1); _Pragma("unroll") for (int m = 0; m < 4; ++m) _Pragma("unroll") for (int n = 0; n < 2; ++n) _Pragma("unroll") for (int k = 0; k < 2; ++k) \
        acc[ai][bj][m][n] = __builtin_amdgcn_mfma_f32_16x16x32_bf16(Bt[n][k], At[m][k], acc[ai][bj][m][n], 0, 0, 0); __builtin_amdgcn_s_setprio(0); } while (0)
#define PG8_WAIT_V(n) asm volatile("s_waitcnt vmcnt(" #n ")" ::: "memory")
#define PG8_WAIT_L(n) asm volatile("s_waitcnt lgkmcnt(" #n ")" ::: "memory")
#define PG8_BAR __builtin_amdgcn_s_barrier()
#define PG8_SCHED __builtin_amdgcn_sched_barrier(0)
    Unit cur, nxt; int ui = 0;
    if (!S.next(0, cur)) return;
    f32x4 acc[2][2][4][2];
#pragma unroll
    for (int a = 0; a < 2; ++a)
#pragma unroll
        for (int b = 0; b < 2; ++b)
#pragma unroll
            for (int m = 0; m < 4; ++m)
#pragma unroll
                for (int n = 0; n < 2; ++n) acc[a][b][m][n] = (f32x4){0.f, 0.f, 0.f, 0.f};
    bf16x8 At[4][2], B0[2][2], B1[2][2];
    const char* cA = (const char*)g.A + (size_t)cur.pm * tstep; const char* cB = (const char*)g.Bt + (size_t)cur.pn * tstep;
    S.a_ready(cur);
    if constexpr (SP2) {
        PG8_STAGE(PG8_SB(0, 0), cB, voffB); PG8_STAGE(PG8_SB(0, 1), cB + hstep, voffB); PG8_STAGE(PG8_SA(0, 0), cA, voffA); PG8_STAGE(PG8_SA(0, 1), cA + hstep, voffA);
        if (wr == 1) PG8_BAR;
        PG8_WAIT_V(2); PG8_BAR;
        PG8_STAGE(PG8_SB(1, 0), cB + kstep, voffB); PG8_STAGE(PG8_SA(1, 0), cA + kstep, voffA); PG8_STAGE(PG8_SB(1, 1), cB + hstep + kstep, voffB);
        PG8_WAIT_V(6); PG8_BAR;
    } else {
        PG8_STAGE(PG8_SB(0, 0), cB, voffB); PG8_STAGE(PG8_SA(0, 0), cA, voffA); PG8_STAGE(PG8_SB(0, 1), cB + hstep, voffB); PG8_STAGE(PG8_SA(0, 1), cA + hstep, voffA);
        if (wr == 1) PG8_BAR;
        PG8_WAIT_V(4); PG8_BAR;
        PG8_STAGE(PG8_SB(1, 0), cB + kstep, voffB); PG8_STAGE(PG8_SA(1, 0), cA + kstep, voffA); PG8_STAGE(PG8_SB(1, 1), cB + hstep + kstep, voffB);
        PG8_WAIT_V(6); PG8_BAR;
    }
    for (;;) {
        const bool has_next = S.next(ui + 1, nxt);
        const char* nA = has_next ? (const char*)g.A + (size_t)nxt.pm * tstep : cA; const char* nB = has_next ? (const char*)g.Bt + (size_t)nxt.pn * tstep : cB;
        for (int t = 0; t < nt; t += 2) {
            const bool last = (t == nt - 2);
            const char* a1 = cA + (size_t)(t + 1) * kstep;
            const char* a2 = last ? nA : cA + (size_t)(t + 2) * kstep; const char* b2 = last ? nB : cB + (size_t)(t + 2) * kstep;
            const char* a3 = a2 + kstep; const char* b3 = b2 + kstep;
            if (last && has_next) S.a_ready(nxt);
            if constexpr (SP2) {
            PG8_LDB(B0, 0, 0); PG8_LDB(B1, 0, 1); PG8_SCHED; PG8_LDA(At, 0, 0); PG8_STAGE(PG8_SA(1, 1), a1 + hstep, voffA);
            PG8_WAIT_V(8); PG8_WAIT_L(0); PG8_BAR; PG8_MMA(0, 0, At, B0); PG8_MMA(0, 1, At, B1); PG8_BAR; PG8_SCHED;
            PG8_LDA(At, 0, 1); PG8_STAGE(PG8_SB(0, 0), b2, voffB); PG8_STAGE(PG8_SB(0, 1), b2 + hstep, voffB); PG8_STAGE(PG8_SA(0, 0), a2, voffA);
            PG8_WAIT_V(8); PG8_WAIT_L(0); PG8_BAR; PG8_MMA(1, 0, At, B0); PG8_MMA(1, 1, At, B1); PG8_BAR; PG8_SCHED;
            PG8_LDB(B0, 1, 0); PG8_LDB(B1, 1, 1); PG8_SCHED; PG8_LDA(At, 1, 0); PG8_STAGE(PG8_SA(0, 1), a2 + hstep, voffA);
            PG8_WAIT_V(8); PG8_WAIT_L(0); PG8_BAR; PG8_MMA(0, 0, At, B0); PG8_MMA(0, 1, At, B1); PG8_BAR; PG8_SCHED;
            PG8_LDA(At, 1, 1); PG8_STAGE(PG8_SB(1, 0), b3, voffB); PG8_STAGE(PG8_SB(1, 1), b3 + hstep, voffB); PG8_STAGE(PG8_SA(1, 0), a3, voffA);
            PG8_WAIT_V(8); PG8_WAIT_L(0); PG8_BAR; PG8_MMA(1, 0, At, B0); PG8_MMA(1, 1, At, B1); PG8_BAR; PG8_SCHED;
            } else {
            PG8_LDB(B0, 0, 0); PG8_SCHED; PG8_LDA(At, 0, 0); PG8_STAGE(PG8_SA(1, 1), a1 + hstep, voffA);
            PG8_WAIT_L(8); PG8_BAR; PG8_WAIT_L(0); PG8_MMA(0, 0, At, B0); PG8_BAR; PG8_SCHED;
            PG8_LDB(B1, 0, 1); PG8_STAGE(PG8_SB(0, 0), b2, voffB);
            PG8_BAR; PG8_WAIT_L(0); PG8_MMA(0, 1, At, B1); PG8_BAR;
            PG8_LDA(At, 0, 1); PG8_STAGE(PG8_SA(0, 0), a2, voffA);
            PG8_BAR; PG8_WAIT_L(0); PG8_MMA(1, 0, At, B0); PG8_BAR; PG8_SCHED;
            PG8_STAGE(PG8_SB(0, 1), b2 + hstep, voffB);
            PG8_WAIT_V(6); PG8_BAR; PG8_MMA(1, 1, At, B1); PG8_BAR;
            PG8_LDB(B0, 1, 0); PG8_SCHED; PG8_LDA(At, 1, 0); PG8_STAGE(PG8_SA(0, 1), a2 + hstep, voffA);
            PG8_WAIT_L(8); PG8_BAR; PG8_WAIT_L(0); PG8_MMA(0, 0, At, B0); PG8_BAR; PG8_SCHED;
            PG8_LDB(B1, 1, 1); PG8_STAGE(PG8_SB(1, 0), b3, voffB);
            PG8_BAR; PG8_WAIT_L(0); PG8_MMA(0, 1, At, B1); PG8_BAR;
            PG8_LDA(At, 1, 1); PG8_STAGE(PG8_SA(1, 0), a3, voffA);
            PG8_BAR; PG8_WAIT_L(0); PG8_MMA(1, 0, At, B0); PG8_BAR; PG8_SCHED;
            PG8_STAGE(PG8_SB(1, 1), b3 + hstep, voffB);
            PG8_WAIT_V(6); PG8_BAR; PG8_MMA(1, 1, At, B1); PG8_BAR;
            }
        }
        if constexpr (ALIGN_EPI) { if (wr == 0) PG8_BAR; }
        if constexpr (!Epi::AFTER_DRAIN) { E(acc, cur, wr, wc, fr, fq); S.done(cur); }
        if (!has_next) break;
#pragma unroll
        for (int a = 0; a < 2; ++a)
#pragma unroll
            for (int b = 0; b < 2; ++b)
#pragma unroll
                for (int m = 0; m < 4; ++m)
#pragma unroll
                    for (int n = 0; n < 2; ++n) acc[a][b][m][n] = (f32x4){0.f, 0.f, 0.f, 0.f};
        cur = nxt; cA = nA; cB = nB; ++ui;
        if constexpr (ALIGN_EPI) { if (wr == 1) PG8_BAR; }
    }
    PG8_WAIT_V(0);
    if constexpr (!ALIGN_EPI) { if (wr == 0) PG8_BAR; }
    PG8_BAR;
    if constexpr (Epi::AFTER_DRAIN) { E.fused(acc, cur, wr, wc, fr, fq, lds, wid, lane); S.done(cur); }
#undef PG8_SA
#undef PG8_SB
#undef PG8_STAGE
#undef PG8_LDA
#undef PG8_LDB
#undef PG8_MMA
#undef PG8_WAIT_V
#undef PG8_WAIT_L
#undef PG8_BAR
#undef PG8_SCHED
}
}

#define LAS __attribute__((address_space(3)))
typedef unsigned short bf16;
typedef short bf16x8 __attribute__((ext_vector_type(8)));
typedef short s16x4 __attribute__((ext_vector_type(4)));
typedef short v4i16_t __attribute__((ext_vector_type(4)));
typedef float f32x4 __attribute__((ext_vector_type(4)));
typedef unsigned u32x4 __attribute__((ext_vector_type(4)));
typedef unsigned u32x2 __attribute__((ext_vector_type(2)));
constexpr int SEQ = 16384, DM = 2048, MTOK = 32768, NATT = 20480, NCONV = 8192, QKVW = 18432;
constexpr float NORM_EPS = 1e-6f;
constexpr int NWAVES = 8, NTHREADS = 512;
constexpr size_t MiB = 1u << 20;
constexpr size_t WS_CTL = 0, CTL_ZERO_BYTES = 65536;
constexpr size_t WS_RS2 = 131072;
constexpr size_t WS_LSE = 1 * MiB;
constexpr size_t WS_WIN = 8 * MiB;
constexpr size_t WS_WOUT = 88 * MiB;
constexpr size_t WS_XB = 96 * MiB;
constexpr size_t WS_Y = 224 * MiB;
constexpr size_t WS_PROJ = 352 * MiB;
constexpr size_t WS_END = 992 * MiB;
constexpr int MISC_OFF = 131072, LDS_BYTES = 131072 + 1024;

__device__ __forceinline__ float wave_sum(float v) {
#pragma unroll
    for (int o = 1; o < 64; o <<= 1) v += __shfl_xor(v, o);
    return v;
}
__device__ __forceinline__ unsigned f2bf(float f) { unsigned u = __builtin_bit_cast(unsigned, f); return (u + 0x7fffu + ((u >> 16) & 1u)) >> 16; }
__device__ __forceinline__ unsigned pk2(float lo, float hi) { return f2bf(lo) | (f2bf(hi) << 16); }
__device__ __forceinline__ float bflo(unsigned w) { return __builtin_bit_cast(float, w << 16); }
__device__ __forceinline__ float bfhi(unsigned w) { return __builtin_bit_cast(float, w & 0xffff0000u); }
#define LDS_WAIT() asm volatile("s_waitcnt lgkmcnt(0)" ::: "memory")

#define XB_TMO      128
#define XB_XCNT(j)  (256  + 64 * (j))
#define XB_XSUB(j)  (1280 + 64 * (j))
#define XB_XGEN(j)  (2304 + 64 * (j))
#define XB_TOP      3328
#define XB_TOPGEN   3392
#define XCD_BAR_WORDS 3456
#define XB_SPIN_CAP (1u << 18)

__device__ __forceinline__ unsigned xb_ld(unsigned* p)              { return __hip_atomic_load(p, __ATOMIC_RELAXED, __HIP_MEMORY_SCOPE_AGENT); }
__device__ __forceinline__ unsigned xb_add(unsigned* p, unsigned v) { return __hip_atomic_fetch_add(p, v, __ATOMIC_RELAXED, __HIP_MEMORY_SCOPE_AGENT); }
__device__ __forceinline__ unsigned xb_xcc_id() { return (unsigned)__builtin_amdgcn_s_getreg((3 << 11) | 20) & 0xFu; }
#define XB_SPIN(cond, bar) do { unsigned _sp = 0; while (cond) { __builtin_amdgcn_s_sleep(1); \
    if ((++_sp & 255u) == 0u) { if (xb_ld(&(bar)[XB_TMO])) break; if (_sp > XB_SPIN_CAP) { atomicAdd(&(bar)[XB_TMO], 1u); break; } } } } while (0)

struct XcdBarrier {
    unsigned* bar; unsigned x;
    volatile LAS unsigned* st;
};

__device__ __forceinline__ XcdBarrier xcd_barrier_post(unsigned* bar, volatile LAS unsigned* st) {
    XcdBarrier b; b.bar = bar; b.x = xb_xcc_id(); b.st = st;
    if (threadIdx.x == 0) (void)xb_add(&bar[XB_XCNT(b.x)], 1u);
    return b;
}
__device__ __forceinline__ void xcd_barrier_complete(unsigned* bar, unsigned x, unsigned& nloc, unsigned& nx) {
    const unsigned G = gridDim.x * gridDim.y * gridDim.z;
    unsigned sum, cnt, mine, sp = 0u;
    for (;;) {
        sum = 0u; cnt = 0u; mine = 0u;
#pragma unroll
        for (unsigned j = 0; j < 16; ++j) { const unsigned c = xb_ld(&bar[XB_XCNT(j)]); sum += c; cnt += (c > 0u) ? 1u : 0u; mine = (j == x) ? c : mine; }
        if (sum == G) break;
        __builtin_amdgcn_s_sleep(1);
        if ((++sp & 255u) == 0u) { if (xb_ld(&bar[XB_TMO])) break; if (sp > XB_SPIN_CAP) { atomicAdd(&bar[XB_TMO], 1u); break; } }
    }
    nloc = mine > 0u ? mine : 1u; nx = cnt > 0u ? cnt : 1u;
}

__device__ __forceinline__ void xcd_barrier(const XcdBarrier& b) {
    asm volatile("s_waitcnt vmcnt(0)" ::: "memory");
    __syncthreads();
    if (threadIdx.x == 0) {
        unsigned* bar = b.bar;
        __builtin_amdgcn_s_waitcnt(0);
        unsigned nloc = b.st[0], nx = b.st[1];
        if (nloc == 0u) { xcd_barrier_complete(bar, b.x, nloc, nx); b.st[0] = nloc; b.st[1] = nx; }
        const unsigned old = xb_add(&bar[XB_XSUB(b.x)], 1u);
        const unsigned gen = old / nloc;
        if (old + 1u == (gen + 1u) * nloc) {
            __builtin_amdgcn_fence(__ATOMIC_RELEASE, "agent");
            asm volatile("s_waitcnt vmcnt(0)" ::: "memory");
            const unsigned og = xb_add(&bar[XB_TOP], 1u);
            const unsigned tg = og / nx;
            if (og + 1u == (tg + 1u) * nx) xb_add(&bar[XB_TOPGEN], 1u);
            else XB_SPIN(xb_ld(&bar[XB_TOPGEN]) == tg, bar);
            __builtin_amdgcn_fence(__ATOMIC_ACQUIRE, "agent");
            xb_add(&bar[XB_XGEN(b.x)], 1u);
            asm volatile("s_waitcnt vmcnt(0)" ::: "memory");
        } else {
            XB_SPIN(xb_ld(&bar[XB_XGEN(b.x)]) == gen, bar);
            __builtin_amdgcn_fence(__ATOMIC_ACQUIRE, "agent");
            asm volatile("s_waitcnt vmcnt(0)" ::: "memory");
        }
    }
    __syncthreads();
}


template <int MAP> __device__ __forceinline__ int rowmap(int sc) {
    if (MAP == 0) return sc;
    const int type = sc >> 11, ch = sc & 2047, pn = ch >> 6, cl = ch & 63;
    return 256 * pn + 128 * (type >> 1) + 32 * (cl >> 4) + 16 * (type & 1) + (cl & 15);
}
template <int MAP> __device__ __forceinline__ void transpose_item(const float* W, const float* gk, int K, int N, bf16* WT, LAS float* scr, int item, int lane) {
    const int nblk = N / 32, kb = item / nblk, nb = item % nblk, k0 = 64 * kb, n0 = 32 * nb;
#pragma unroll 8
    for (int i = 0; i < 32; ++i) { const int kk = 2 * i + (lane >> 5); scr[kk * 33 + (lane & 31)] = W[(size_t)(k0 + kk) * N + n0 + (lane & 31)] * (gk ? gk[k0 + kk] : 1.0f); }
    LDS_WAIT(); asm volatile("" ::: "memory");
    const int c = lane & 7;
#pragma unroll
    for (int j = 0; j < 4; ++j) { const int n = (lane >> 3) + 8 * j; const LAS float* s = scr + (8 * c) * 33 + n;
        u32x4 o; o.x = pk2(s[0 * 33], s[1 * 33]); o.y = pk2(s[2 * 33], s[3 * 33]); o.z = pk2(s[4 * 33], s[5 * 33]); o.w = pk2(s[6 * 33], s[7 * 33]);
        *(u32x4*)(WT + (size_t)rowmap<MAP>(n0 + n) * K + k0 + 8 * c) = o; }
    LDS_WAIT(); asm volatile("" ::: "memory");
}

template <int MODE> __device__ __forceinline__ void resid_rows(const float* xin, bf16* xb, const bf16* y2, float* out, float* rs2, const float* gpost, int gw, int ngw, int lane) {
    f32x4 gp[8];
#pragma unroll
    for (int j = 0; j < 4; ++j) { if (MODE != 0) { gp[2 * j] = ((const f32x4*)gpost)[2 * (64 * j + lane)]; gp[2 * j + 1] = ((const f32x4*)gpost)[2 * (64 * j + lane) + 1]; } }
    for (int m = gw; m < MTOK; m += ngw) {
        f32x4 v[8];
        if (MODE == 0) { const f32x4* xr = (const f32x4*)(xin + (size_t)m * DM);
#pragma unroll
            for (int j = 0; j < 4; ++j) { v[2 * j] = xr[2 * (64 * j + lane)]; v[2 * j + 1] = xr[2 * (64 * j + lane) + 1]; }
        } else {
            const u32x4* xr = (const u32x4*)(xb + (size_t)m * DM); const u32x4* yr = (const u32x4*)(y2 + (size_t)m * DM);
            u32x4 xw[4], yw[4];
#pragma unroll
            for (int j = 0; j < 4; ++j) { xw[j] = xr[64 * j + lane]; yw[j] = yr[64 * j + lane]; }
            f32x4 y[8]; float ss = 0.f;
#pragma unroll
            for (int j = 0; j < 4; ++j) {
                y[2 * j] = (f32x4){bflo(yw[j].x), bfhi(yw[j].x), bflo(yw[j].y), bfhi(yw[j].y)}; y[2 * j + 1] = (f32x4){bflo(yw[j].z), bfhi(yw[j].z), bflo(yw[j].w), bfhi(yw[j].w)};
                v[2 * j] = (f32x4){bflo(xw[j].x), bfhi(xw[j].x), bflo(xw[j].y), bfhi(xw[j].y)}; v[2 * j + 1] = (f32x4){bflo(xw[j].z), bfhi(xw[j].z), bflo(xw[j].w), bfhi(xw[j].w)};
            }
#pragma unroll
            for (int j = 0; j < 8; ++j) ss += (y[j].x * y[j].x + y[j].y * y[j].y) + (y[j].z * y[j].z + y[j].w * y[j].w);
            const float rs = 1.0f / sqrtf(wave_sum(ss) * (1.0f / DM) + NORM_EPS);
#pragma unroll
            for (int j = 0; j < 8; ++j) v[j] = v[j] + y[j] * rs * gp[j];
        }
        if (MODE == 2) { f32x4* orow = (f32x4*)(out + (size_t)m * DM);
#pragma unroll
            for (int j = 0; j < 4; ++j) { orow[2 * (64 * j + lane)] = v[2 * j]; orow[2 * (64 * j + lane) + 1] = v[2 * j + 1]; }
        } else {
            float ss = 0.f;
#pragma unroll
            for (int j = 0; j < 8; ++j) ss += (v[j].x * v[j].x + v[j].y * v[j].y) + (v[j].z * v[j].z + v[j].w * v[j].w);
            const float r2 = 1.0f / sqrtf(wave_sum(ss) * (1.0f / DM) + NORM_EPS);
            u32x4* o = (u32x4*)(xb + (size_t)m * DM);
#pragma unroll
            for (int j = 0; j < 4; ++j) { u32x4 w; w.x = pk2(v[2 * j].x, v[2 * j].y); w.y = pk2(v[2 * j].z, v[2 * j].w); w.z = pk2(v[2 * j + 1].x, v[2 * j + 1].y); w.w = pk2(v[2 * j + 1].z, v[2 * j + 1].w); o[64 * j + lane] = w; }
            if (lane == 0) rs2[m] = r2;
        }
    }
}

__device__ __forceinline__ void conv_phase(const bf16* U, const bf16* VG, const float* cw, bf16* Y, int gtid, int nthr) {
    for (int item = gtid; item < 256 * (MTOK / 32); item += nthr) {
        const int chunk = item & 255, run = item >> 8, ch0 = chunk * 8, row0 = run * 32;
        float w0[8], w1[8], w2[8], um1[8], um2[8];
#pragma unroll
        for (int j = 0; j < 8; ++j) { w0[j] = cw[ch0 + j]; w1[j] = cw[DM + ch0 + j]; w2[j] = cw[2 * DM + ch0 + j]; um1[j] = 0.f; um2[j] = 0.f; }
        if ((row0 & (SEQ - 1)) != 0) {
            const u32x4 a = *(const u32x4*)(U + (size_t)(row0 - 1) * DM + ch0), b = *(const u32x4*)(U + (size_t)(row0 - 2) * DM + ch0);
#pragma unroll
            for (int j = 0; j < 4; ++j) { um1[2 * j] = bflo(a[j]); um1[2 * j + 1] = bfhi(a[j]); um2[2 * j] = bflo(b[j]); um2[2 * j + 1] = bfhi(b[j]); }
        }
#pragma unroll 8
        for (int i = 0; i < 32; ++i) {
            const size_t off = (size_t)(row0 + i) * DM + ch0;
            const u32x4 uu = *(const u32x4*)(U + off), vv = *(const u32x4*)(VG + off); u32x4 o;
#pragma unroll
            for (int j = 0; j < 4; ++j) {
                const float u0 = bflo(uu[j]), u1 = bfhi(uu[j]);
                const float y0 = bflo(vv[j]) * (w0[2 * j] * um2[2 * j] + w1[2 * j] * um1[2 * j] + w2[2 * j] * u0);
                const float y1 = bfhi(vv[j]) * (w0[2 * j + 1] * um2[2 * j + 1] + w1[2 * j + 1] * um1[2 * j + 1] + w2[2 * j + 1] * u1);
                o[j] = pk2(y0, y1); um2[2 * j] = um1[2 * j]; um2[2 * j + 1] = um1[2 * j + 1]; um1[2 * j] = u0; um1[2 * j + 1] = u1;
            }
            *(u32x4*)(Y + off) = o;
        }
    }
}

__device__ __forceinline__ s16x4 vtr(const LAS unsigned char* p) { return __builtin_bit_cast(s16x4, __builtin_amdgcn_ds_read_tr16_b64_v4i16((LAS v4i16_t*)p)); }
struct AttnPre { u32x4 k[8]; bf16x8 q[4]; };
__device__ __forceinline__ void attn_decode(int U, int gbase, int& g, int& h, int& r, int& c, int& d) {
    const int gh = U >> 7, uid = U & 127; g = gbase + (gh >> 4); h = gh & 15;
    d = (g == 0) ? 1 : (g == 1 ? 4 : 16); const int nblk = 128 / d; r = uid / nblk; c = uid % nblk;
}
__device__ __forceinline__ void attn_load_rows(u32x4 (&dst)[8], const bf16* proj, int col0, int r, int c, int d, int tid) {
    const int chunk = tid & 15;
#pragma unroll
    for (int p = 0; p < 8; ++p) {
        const int j = p * 32 + (tid >> 4), u = 128 * c - 128 + j;
        if (u >= 0) dst[p] = *(const u32x4*)(proj + (size_t)(u * d + r) * NATT + col0 + chunk * 8);
        else dst[p] = (u32x4){0u, 0u, 0u, 0u};
    }
}
__device__ __forceinline__ void attn_prefetch(AttnPre& P, const bf16* proj, int g, int h, int r, int c, int d, int tid, int wave, int lane) {
    attn_load_rows(P.k, proj, ((3 + g) * 16 + h) * 128, r, c, d, tid);
    const size_t qrow = (size_t)((128 * c + 16 * wave + (lane & 15)) * d + r) * NATT + (g * 16 + h) * 128 + 8 * (lane >> 4);
#pragma unroll
    for (int kk = 0; kk < 4; ++kk) P.q[kk] = *(const bf16x8*)(proj + qrow + 32 * kk);
}
template <bool MERGE> __device__ __forceinline__ void attn_phase(LAS unsigned char* lds, bf16* proj, float* lse, bf16* Y, int gbase, int nunits, int vcu, int G) {
    int tid_ = threadIdx.x; asm volatile("" : "+v"(tid_));
    const int tid = tid_, lane = tid & 63, wave = __builtin_amdgcn_readfirstlane(tid >> 6), l15 = lane & 15, fg = lane >> 4, r4 = (lane & 15) >> 2, cc = lane & 3;
    LAS unsigned char* Kl = lds; LAS unsigned char* Vl = lds + 65536;
    int U = vcu; if (U >= nunits) return;
    int g, h, r, c, d; attn_decode(U, gbase, g, h, r, c, d);
    AttnPre P; attn_prefetch(P, proj, g, h, r, c, d, tid, wave, lane);
    const int x7 = 4 * (fg & 1) + r4;
    const int jrow = tid >> 4, chunk = tid & 15;
    const int kwoff = jrow * 256 + ((chunk ^ (jrow & 15)) << 4), vwoff = jrow * 256 + (((((chunk >> 1) ^ (jrow & 7)) << 1) | (chunk & 1)) << 4);
    const LAS unsigned char* kbase = Kl + (16 * wave + l15) * 256;
    int kx[4];
#pragma unroll
    for (int kk = 0; kk < 4; ++kk) kx[kk] = ((4 * kk + fg) ^ l15) << 4;
    const LAS unsigned char* vbase = Vl + (16 * wave + 4 * fg + r4) * 256 + 8 * cc;
    for (;;) {
#pragma unroll
        for (int p = 0; p < 8; ++p) *(LAS u32x4*)(Kl + kwoff + p * 8192) = P.k[p];
        u32x4 vreg[8];
        attn_load_rows(vreg, proj, ((6 + g) * 16 + h) * 128, r, c, d, tid);
        bf16x8 q[4];
#pragma unroll
        for (int kk = 0; kk < 4; ++kk) q[kk] = P.q[kk];
        const int cg = g, ch = h, cr = r, cb = c, cd = d;
        __syncthreads();
        f32x4 sacc[9];
#pragma unroll
        for (int tt = 0; tt < 9; ++tt) { sacc[tt] = (f32x4){0.f, 0.f, 0.f, 0.f};
#pragma unroll
            for (int kk = 0; kk < 4; ++kk) { const bf16x8 kf = *(const LAS bf16x8*)(kbase + tt * 4096 + kx[kk]); sacc[tt] = __builtin_amdgcn_mfma_f32_16x16x32_bf16(kf, q[kk], sacc[tt], 0, 0, 0); } }
        const float slope = __builtin_amdgcn_exp2f(-8.0f * (float)(cg * 16 + ch + 1) / 48.0f);
        const float sc2 = 0.08838834764831845f * 1.4426950408889634f, sl2 = slope * (float)cd * 1.4426950408889634f;
        float mx = -3.0e38f;
#pragma unroll
        for (int tt = 0; tt < 9; ++tt)
#pragma unroll
            for (int e = 0; e < 4; ++e) {
                const int dist = 128 + l15 - 16 * tt - 4 * fg - e, kj = 16 * (wave + tt) + 4 * fg + e;
                const bool valid = (dist >= 0) && (dist <= 128) && (cb > 0 || kj >= 128);
                const float s = valid ? (sacc[tt][e] * sc2 - sl2 * (float)dist) : -3.0e38f;
                sacc[tt][e] = s; mx = fmaxf(mx, s);
            }
        mx = fmaxf(mx, __shfl_xor(mx, 16)); mx = fmaxf(mx, __shfl_xor(mx, 32));
        float sum = 0.f; bf16x8 pf[5];
#pragma unroll
        for (int pp = 0; pp < 5; ++pp) {
            float p0[4], p1[4];
#pragma unroll
            for (int e = 0; e < 4; ++e) { p0[e] = __builtin_amdgcn_exp2f(sacc[2 * pp][e] - mx); p1[e] = (pp < 4) ? __builtin_amdgcn_exp2f(sacc[(pp < 4) ? 2 * pp + 1 : 0][e] - mx) : 0.f; sum += p0[e] + p1[e]; }
            u32x4 w; w.x = pk2(p0[0], p0[1]); w.y = pk2(p0[2], p0[3]); w.z = pk2(p1[0], p1[1]); w.w = pk2(p1[2], p1[3]);
            pf[pp] = __builtin_bit_cast(bf16x8, w);
        }
        sum += __shfl_xor(sum, 16); sum += __shfl_xor(sum, 32);
#pragma unroll
        for (int p = 0; p < 8; ++p) *(LAS u32x4*)(Vl + vwoff + p * 8192) = vreg[p];
        __syncthreads();
        const int Un = U + G; const bool has_next = Un < nunits;
        if (has_next) { attn_decode(Un, gbase, g, h, r, c, d); attn_prefetch(P, proj, g, h, r, c, d, tid, wave, lane); }
        f32x4 oacc[8];
#pragma unroll
        for (int c8 = 0; c8 < 8; ++c8) oacc[c8] = (f32x4){0.f, 0.f, 0.f, 0.f};
#pragma unroll
        for (int pp = 0; pp < 5; ++pp) {
#pragma unroll
            for (int c8 = 0; c8 < 8; ++c8) {
                const LAS unsigned char* vp = vbase + ((c8 ^ x7) << 5);
                const s16x4 a0 = vtr(vp + (2 * pp) * 4096);
                s16x4 a1 = (s16x4){0, 0, 0, 0}; if (pp < 4) a1 = vtr(vp + (2 * pp + 1) * 4096);
                bf16x8 a; a[0] = a0[0]; a[1] = a0[1]; a[2] = a0[2]; a[3] = a0[3]; a[4] = a1[0]; a[5] = a1[1]; a[6] = a1[2]; a[7] = a1[3];
                oacc[c8] = __builtin_amdgcn_mfma_f32_16x16x32_bf16(a, pf[pp], oacc[c8], 0, 0, 0);
            }
        }
        const int tok = (128 * cb + 16 * wave + l15) * cd + cr;
        const float lse2 = mx + __builtin_amdgcn_logf(sum);
        if (!MERGE) {
            const float inv = 1.0f / sum;
            bf16* orow = proj + (size_t)tok * NATT + (cg * 16 + ch) * 128 + 4 * fg;
#pragma unroll
            for (int c8 = 0; c8 < 8; ++c8) { u32x2 w; w.x = pk2(oacc[c8][0] * inv, oacc[c8][1] * inv); w.y = pk2(oacc[c8][2] * inv, oacc[c8][3] * inv); *(u32x2*)(orow + 16 * c8) = w; }
            if (fg == 0) lse[((size_t)(cg - 1) * SEQ + tok) * 16 + ch] = lse2;
        } else {
            const float l1 = lse[((size_t)0 * SEQ + tok) * 16 + ch], l2 = lse[((size_t)1 * SEQ + tok) * 16 + ch];
            const float mm = fmaxf(lse2, fmaxf(l1, l2));
            const float w0 = __builtin_amdgcn_exp2f(lse2 - mm), w1 = __builtin_amdgcn_exp2f(l1 - mm), w2 = __builtin_amdgcn_exp2f(l2 - mm);
            const float inv = 1.0f / (w0 + w1 + w2), k0 = w0 * inv / sum, k1 = w1 * inv, k2 = w2 * inv;
            const bf16* prow = proj + (size_t)tok * NATT + 4 * fg;
            bf16* yrow = Y + (size_t)tok * DM + ch * 128 + 4 * fg;
#pragma unroll
            for (int c8 = 0; c8 < 8; ++c8) {
                const u32x2 o1 = *(const u32x2*)(prow + (16 + ch) * 128 + 16 * c8), o2 = *(const u32x2*)(prow + (32 + ch) * 128 + 16 * c8), gt = *(const u32x2*)(prow + QKVW + ch * 128 + 16 * c8);
                float y[4];
                y[0] = oacc[c8][0] * k0 + bflo(o1.x) * k1 + bflo(o2.x) * k2; y[1] = oacc[c8][1] * k0 + bfhi(o1.x) * k1 + bfhi(o2.x) * k2;
                y[2] = oacc[c8][2] * k0 + bflo(o1.y) * k1 + bflo(o2.y) * k2; y[3] = oacc[c8][3] * k0 + bfhi(o1.y) * k1 + bfhi(o2.y) * k2;
                y[0] *= pg8::silu_f(bflo(gt.x)); y[1] *= pg8::silu_f(bfhi(gt.x)); y[2] *= pg8::silu_f(bflo(gt.y)); y[3] *= pg8::silu_f(bfhi(gt.y));
                u32x2 w; w.x = pk2(y[0], y[1]); w.y = pk2(y[2], y[3]); *(u32x2*)(yrow + 16 * c8) = w;
            }
        }
        if (!has_next) break;
        U = Un;
    }
    __syncthreads();
}

struct Args { const float* in[19]; float* out; unsigned char* ws; };
__global__ void __launch_bounds__(NTHREADS, 2) mega_fwd(Args a) {
    extern __shared__ __attribute__((aligned(16))) unsigned char lds_raw[];
    cg::grid_group grid = cg::this_grid();
    LAS unsigned char* lds = (LAS unsigned char*)lds_raw;
    const int G = gridDim.x, bx = blockIdx.x;
    const int vcu = (G % 8 == 0) ? (bx % 8) * (G / 8) + bx / 8 : bx;
    const int ngw = G * NWAVES;
    unsigned char* ws = a.ws;
    bf16* WIN = (bf16*)(ws + WS_WIN); bf16* WOUT = (bf16*)(ws + WS_WOUT); bf16* XB = (bf16*)(ws + WS_XB); bf16* YB = (bf16*)(ws + WS_Y); bf16* PROJ = (bf16*)(ws + WS_PROJ);
    float* LSE = (float*)(ws + WS_LSE); float* RS2 = (float*)(ws + WS_RS2); bf16* Y2 = (bf16*)(ws + WS_PROJ);
    volatile LAS unsigned* MISC = (volatile LAS unsigned*)(lds + MISC_OFF);
    if (threadIdx.x < 64) MISC[threadIdx.x] = 0u;
    __syncthreads();
    const XcdBarrier bar = xcd_barrier_post((unsigned*)(ws + WS_CTL), MISC + 8);
    bool first_seam = true;
#define SEAM() do { if (first_seam) { grid.sync(); first_seam = false; } else xcd_barrier(bar); } while (0)

#pragma nounroll
    for (int layer = 0; layer < 4; ++layer) {
        const bool is_attn = (layer & 1) == 0;
        const int base = 1 + 9 * (layer >> 1) + (is_attn ? 0 : 4);
        const float* g_pre = a.in[base]; const float* w_in = a.in[base + 1];
        const float* conv_w = a.in[base + 2];
        const float* w_out = a.in[base + (is_attn ? 2 : 3)];
        const float* g_post_prev = a.in[layer == 0 ? 4 : (layer == 1 ? 4 : (layer == 2 ? 9 : 13))];
        int tid_ = threadIdx.x; asm volatile("" : "+v"(tid_));
        const int tid = tid_, lane = tid & 63, wave = __builtin_amdgcn_readfirstlane(tid >> 6), gw = bx * NWAVES + wave;
        LAS float* scr = (LAS float*)(lds + wave * 16384);
        if (is_attn) { const int items_in = (DM / 64) * (NATT / 32);
            for (int it = gw; it < items_in; it += ngw) transpose_item<0>(w_in, g_pre, DM, NATT, WIN, scr, it, lane);
        } else { const int items_in = (DM / 64) * (NCONV / 32);
            for (int it = gw; it < items_in; it += ngw) transpose_item<1>(w_in, g_pre, DM, NCONV, WIN, scr, it, lane);
        }
        { const int items_out = (DM / 64) * (DM / 32);
            for (int it = gw; it < items_out; it += ngw) transpose_item<0>(w_out, nullptr, DM, DM, WOUT, scr, it, lane); }
        if (layer == 0) resid_rows<0>(a.in[0], XB, nullptr, nullptr, RS2, nullptr, gw, ngw, lane);
        else resid_rows<1>(nullptr, XB, Y2, nullptr, RS2, g_post_prev, gw, ngw, lane);
        SEAM();
        if (is_attn) {
#pragma nounroll
            for (int half = 0; half < 2; ++half) {
                { pg8::Gemm g{XB + (size_t)half * SEQ * DM, WIN, SEQ, NATT, DM}; pg8::StaticOrder So; So.init(SEQ, NATT, G, bx);
                  pg8::EpiBf16P E{PROJ, NATT, RS2 + half * SEQ};
                  pg8::gemm_phase<pg8::EpiBf16P, pg8::StaticOrder, true, true>(lds, g, So, E); }
                SEAM();
                attn_phase<false>(lds, PROJ, LSE, nullptr, 1, 2 * 16 * 128, vcu, G);
                SEAM();
                attn_phase<true>(lds, PROJ, LSE, YB + (size_t)half * SEQ * DM, 0, 16 * 128, vcu, G);
                SEAM();
            }
        } else {
            { pg8::Gemm g{XB, WIN, MTOK, NCONV, DM}; pg8::StaticOrder So; So.init(MTOK, NCONV, G, bx);
              pg8::EpiConv E{PROJ, PROJ + (size_t)MTOK * DM, DM, RS2};
              pg8::gemm_phase<pg8::EpiConv, pg8::StaticOrder, true, true>(lds, g, So, E); }
            SEAM();
            { int t2 = threadIdx.x; asm volatile("" : "+v"(t2)); conv_phase(PROJ, PROJ + (size_t)MTOK * DM, conv_w, YB, bx * NTHREADS + t2, G * NTHREADS); }
            SEAM();
        }
        { pg8::Gemm g{YB, WOUT, MTOK, DM, DM}; pg8::StaticOrder So; So.init(MTOK, DM, G, bx);
          pg8::EpiBf16P E{Y2, DM, nullptr};
          pg8::gemm_phase<pg8::EpiBf16P, pg8::StaticOrder, true, true>(lds, g, So, E); }
        SEAM();
    }
    { int t3 = threadIdx.x; asm volatile("" : "+v"(t3)); const int wave3 = __builtin_amdgcn_readfirstlane(t3 >> 6);
      resid_rows<2>(nullptr, XB, Y2, a.out, nullptr, a.in[18], bx * NWAVES + wave3, ngw, t3 & 63); }
#undef SEAM
}

extern "C" void kernel_launch(void* const* d_in, const int* in_sizes, int n_in, void* d_out, int out_size, void* d_ws, size_t ws_size, hipStream_t stream) {
    static int grid = 0;
    if (grid == 0) {
        if (n_in != 19 || ws_size < WS_END) { fprintf(stderr, "kernel_launch: unexpected n_in %d or ws_size %zu (need %zu)\n", n_in, ws_size, (size_t)WS_END); grid = -1; return; }
        int dev = 0, cus = 0, per_cu = 0;
        (void)hipGetDevice(&dev); (void)hipDeviceGetAttribute(&cus, hipDeviceAttributeMultiprocessorCount, dev);
        if (hipFuncSetAttribute((const void*)mega_fwd, hipFuncAttributeMaxDynamicSharedMemorySize, LDS_BYTES) != hipSuccess) { fprintf(stderr, "kernel_launch: hipFuncSetAttribute failed\n"); grid = -1; return; }
        if (hipOccupancyMaxActiveBlocksPerMultiprocessor(&per_cu, (const void*)mega_fwd, NTHREADS, LDS_BYTES) != hipSuccess || per_cu < 1) { fprintf(stderr, "kernel_launch: occupancy query gave %d\n", per_cu); per_cu = 1; }
        (void)hipGetLastError();
        grid = cus * 1;
    }
    if (grid < 0) return;
    if (hipMemsetAsync((char*)d_ws + WS_CTL, 0, CTL_ZERO_BYTES, stream) != hipSuccess) { fprintf(stderr, "kernel_launch: hipMemsetAsync failed\n"); return; }
    Args a{};
    for (int i = 0; i < 19; ++i) a.in[i] = (const float*)d_in[i];
    a.out = (float*)d_out; a.ws = (unsigned char*)d_ws;
    void* args[] = {&a};
    hipError_t e = hipLaunchCooperativeKernel((const void*)mega_fwd, dim3(grid), dim3(NTHREADS), args, LDS_BYTES, stream);
    if (e != hipSuccess) fprintf(stderr, "cooperative launch failed: %s (grid %d)\n", hipGetErrorString(e), grid);
}
```
